# Optimizing an MI355X kernel written in HIP

```python
import math
import jax, jax.numpy as jnp
from jax import lax
import numpy as np

D_MODEL = 1024
BATCH = 2
SEQ = 8192
DEPTH = 2

CTX_LEN = 256
GRID_W = 64

MLA_HEADS = 8
QK_NOPE_DIM = 64
QK_ROPE_DIM = 32
QK_HEAD_DIM = QK_NOPE_DIM + QK_ROPE_DIM
V_HEAD_DIM = 64
Q_LORA_RANK = 256
KV_LORA_RANK = 128
MLA_OUT = MLA_HEADS * V_HEAD_DIM

CONV_DIM = 512
CONV_K = 3

IN_SPLITS = [Q_LORA_RANK,
             Q_LORA_RANK + KV_LORA_RANK,
             Q_LORA_RANK + KV_LORA_RANK + QK_ROPE_DIM,
             Q_LORA_RANK + KV_LORA_RANK + QK_ROPE_DIM + CONV_DIM,
             Q_LORA_RANK + KV_LORA_RANK + QK_ROPE_DIM + 2 * CONV_DIM]
D_IN = Q_LORA_RANK + KV_LORA_RANK + QK_ROPE_DIM + 3 * CONV_DIM
KV_COL_START = Q_LORA_RANK
KV_COL_END = Q_LORA_RANK + KV_LORA_RANK + QK_ROPE_DIM
MIX_WIDTH = MLA_OUT + CONV_DIM

D_FF = 2816
N_MOD = 9
ROPE_BASE = 10000.0
EPS = 1e-6
Q_BLOCK = 128
ATTN_SCALE = 1.0 / math.sqrt(QK_HEAD_DIM)

kernel_name = "hybrid_mla_shortconv_macaron_dit"


def rmsnorm(x, w):
    x32 = x.astype(jnp.float32)
    r = lax.rsqrt(jnp.mean(x32 * x32, axis=-1, keepdims=True) + EPS)
    return (x32 * r).astype(x.dtype) * w


def modulate(h, shift, scale):
    return h * (1 + scale) + shift


def swiglu(h, w_i, w_o):
    g, u = jnp.split(h @ w_i, 2, axis=-1)
    return (jax.nn.silu(g) * u) @ w_o


def axial_rope_tables(rows, dtype):
    t = jnp.arange(rows * GRID_W)
    row = (t // GRID_W).astype(jnp.float32)
    col = (t % GRID_W).astype(jnp.float32)
    d_axis = QK_ROPE_DIM // 2
    inv = ROPE_BASE ** (-jnp.arange(0, d_axis, 2, dtype=jnp.float32) / d_axis)
    ar = row[:, None] * inv
    ac = col[:, None] * inv
    return tuple(a.astype(dtype) for a in (jnp.cos(ar), jnp.sin(ar), jnp.cos(ac), jnp.sin(ac)))


def rotate(x, cos, sin):
    x1, x2 = jnp.split(x, 2, axis=-1)
    return jnp.concatenate([x1 * cos - x2 * sin, x2 * cos + x1 * sin], axis=-1)


def axial_rope(x, tabs):
    cr, sr, cc, sc = tabs
    xr, xc = jnp.split(x, 2, axis=-1)
    return jnp.concatenate([rotate(xr, cr, sr), rotate(xc, cc, sc)], axis=-1)


def attend(q, k, v):
    s = jnp.einsum('bqhd,bkhd->bhqk', q, k, preferred_element_type=jnp.float32) * ATTN_SCALE
    p = jax.nn.softmax(s, axis=-1).astype(v.dtype)
    return jnp.einsum('bhqk,bkhd->bqhd', p, v)


def blocked_attend(q, k, v):
    b, l, h, d = q.shape
    nb = l // Q_BLOCK
    qb = q.reshape(b, nb, Q_BLOCK, h, d).transpose(1, 0, 2, 3, 4)
    ob = lax.map(lambda qi: attend(qi, k, v), qb)
    return ob.transpose(1, 0, 2, 3, 4).reshape(b, l, h, v.shape[-1])


def mla_queries(cq, q_norm_w, w_uq, tabs):
    b, l, _ = cq.shape
    q = (rmsnorm(cq, q_norm_w) @ w_uq).reshape(b, l, MLA_HEADS, QK_HEAD_DIM)
    q_nope, q_pe = q[..., :QK_NOPE_DIM], q[..., QK_NOPE_DIM:]
    if tabs is not None:
        q_pe = axial_rope(q_pe, tuple(t[:, None, :] for t in tabs))
    return jnp.concatenate([q_nope, q_pe], axis=-1)


def mla_keys_values(ckv, k_pe, kv_norm_w, w_ukv, tabs):
    b, l, _ = ckv.shape
    kv = (rmsnorm(ckv, kv_norm_w) @ w_ukv).reshape(b, l, MLA_HEADS, QK_NOPE_DIM + V_HEAD_DIM)
    k_nope, v = kv[..., :QK_NOPE_DIM], kv[..., QK_NOPE_DIM:]
    if tabs is not None:
        k_pe = axial_rope(k_pe, tabs)
    k_pe = jnp.broadcast_to(k_pe[:, :, None, :], (b, l, MLA_HEADS, QK_ROPE_DIM))
    return jnp.concatenate([k_nope, k_pe], axis=-1), v


def short_conv(u, w):
    up = jnp.pad(u, ((0, 0), (1, 1), (0, 0)))
    return up[:, :-2] * w[0] + up[:, 1:-1] * w[1] + up[:, 2:] * w[2]


def token_mixer(hl, hc, w_in, q_norm_w, kv_norm_w, w_uq, w_ukv, conv_w, w_out, tabs, ctx_out):
    b, l, _ = hl.shape
    cq_l, ckv_l, kpe_l, gb_l, gc_l, xv_l = jnp.split(hl @ w_in, IN_SPLITS, axis=-1)
    if ctx_out:
        cq_c, ckv_c, kpe_c, gb_c, gc_c, xv_c = jnp.split(hc @ w_in, IN_SPLITS, axis=-1)
    else:
        ckv_c, kpe_c = jnp.split(hc @ w_in[:, KV_COL_START:KV_COL_END], [KV_LORA_RANK], axis=-1)
    k_c, v_c = mla_keys_values(ckv_c, kpe_c, kv_norm_w, w_ukv, None)
    k_l, v_l = mla_keys_values(ckv_l, kpe_l, kv_norm_w, w_ukv, tabs)
    q_l = mla_queries(cq_l, q_norm_w, w_uq, tabs)
    k_all = jnp.concatenate([k_c, k_l], axis=1)
    v_all = jnp.concatenate([v_c, v_l], axis=1)
    att_l = blocked_attend(q_l, k_all, v_all).reshape(b, l, MLA_OUT)
    conv_l = gb_l * short_conv(gc_l * xv_l, conv_w)
    out_l = jnp.concatenate([att_l, conv_l], axis=-1) @ w_out
    if not ctx_out:
        return out_l, None
    q_c = mla_queries(cq_c, q_norm_w, w_uq, None)
    att_c = attend(q_c, k_c, v_c).reshape(hc.shape[0], hc.shape[1], MLA_OUT)
    conv_c = gb_c * short_conv(gc_c * xv_c, conv_w)
    out_c = jnp.concatenate([att_c, conv_c], axis=-1) @ w_out
    return out_l, out_c


def trunk_layer(xl, xc, ml, mc, norm_w, w_ffn1_in, w_ffn1_out, w_ffn2_in, w_ffn2_out,
                w_in, q_norm_w, kv_norm_w, w_uq, w_ukv, conv_w, w_out, tabs, last):
    sh1l, sc1l, g1l, sh2l, sc2l, g2l, sh3l, sc3l, g3l = ml
    sh1c, sc1c, g1c, sh2c, sc2c, g2c, sh3c, sc3c, g3c = mc
    xl = xl + 0.5 * g1l * swiglu(modulate(rmsnorm(xl, norm_w[0]), sh1l, sc1l), w_ffn1_in, w_ffn1_out)
    xc = xc + 0.5 * g1c * swiglu(modulate(rmsnorm(xc, norm_w[0]), sh1c, sc1c), w_ffn1_in, w_ffn1_out)
    hl = modulate(rmsnorm(xl, norm_w[1]), sh2l, sc2l)
    hc = modulate(rmsnorm(xc, norm_w[1]), sh2c, sc2c)
    mix_l, mix_c = token_mixer(hl, hc, w_in, q_norm_w, kv_norm_w, w_uq, w_ukv, conv_w, w_out,
                               tabs, not last)
    xl = xl + g2l * mix_l
    xl = xl + 0.5 * g3l * swiglu(modulate(rmsnorm(xl, norm_w[2]), sh3l, sc3l), w_ffn2_in, w_ffn2_out)
    if not last:
        xc = xc + g2c * mix_c
        xc = xc + 0.5 * g3c * swiglu(modulate(rmsnorm(xc, norm_w[2]), sh3c, sc3c), w_ffn2_in, w_ffn2_out)
    return xl, xc


def setup_inputs(seed: int = 0) -> dict:
    key = jax.random.key(seed)
    ks = jax.random.split(key, 20)
    f32 = jnp.float32

    def dense(k, shape, fan_in, gain=1.0):
        return jax.random.normal(k, shape, f32) * (gain * fan_in ** -0.5)

    def gains(k, shape):
        return 1.0 + 0.05 * jax.random.normal(k, shape, f32)

    return {
        "x": jax.random.normal(ks[0], (BATCH, SEQ, D_MODEL), f32),
        "c": jax.random.normal(ks[1], (BATCH, D_MODEL), f32),
        "ctx": jax.random.normal(ks[2], (BATCH, CTX_LEN, D_MODEL), f32),
        "c_ctx": jax.random.normal(ks[3], (D_MODEL,), f32),
        "w_ada": dense(ks[4], (DEPTH, D_MODEL, N_MOD * D_MODEL), D_MODEL, 0.5),
        "b_ada": 0.01 * jax.random.normal(ks[5], (DEPTH, N_MOD * D_MODEL), f32),
        "norm_w": gains(ks[6], (DEPTH, 3, D_MODEL)),
        "w_ffn1_in": dense(ks[7], (DEPTH, D_MODEL, 2 * D_FF), D_MODEL),
        "w_ffn1_out": dense(ks[8], (DEPTH, D_FF, D_MODEL), D_FF),
        "w_ffn2_in": dense(ks[9], (DEPTH, D_MODEL, 2 * D_FF), D_MODEL),
        "w_ffn2_out": dense(ks[10], (DEPTH, D_FF, D_MODEL), D_FF),
        "w_in": dense(ks[11], (DEPTH, D_MODEL, D_IN), D_MODEL),
        "q_norm_w": gains(ks[12], (DEPTH, Q_LORA_RANK)),
        "kv_norm_w": gains(ks[13], (DEPTH, KV_LORA_RANK)),
        "w_uq": dense(ks[14], (DEPTH, Q_LORA_RANK, MLA_HEADS * QK_HEAD_DIM), Q_LORA_RANK),
        "w_ukv": dense(ks[15], (DEPTH, KV_LORA_RANK, MLA_HEADS * (QK_NOPE_DIM + V_HEAD_DIM)), KV_LORA_RANK),
        "conv_w": dense(ks[16], (DEPTH, CONV_K, CONV_DIM), CONV_K),
        "w_out": dense(ks[17], (DEPTH, MIX_WIDTH, D_MODEL), MIX_WIDTH),
        "final_norm_w": gains(ks[18], (D_MODEL,)),
    }


def reference(x, c, ctx, c_ctx, w_ada, b_ada, norm_w, w_ffn1_in, w_ffn1_out, w_ffn2_in, w_ffn2_out,
              w_in, q_norm_w, kv_norm_w, w_uq, w_ukv, conv_w, w_out, final_norm_w):
    n_tokens = x.shape[1]
    rows = n_tokens // GRID_W
    tabs = axial_rope_tables(rows, x.dtype)
    xl, xc = x, ctx
    for i in range(DEPTH):
        last = i == DEPTH - 1
        ml = jnp.split((jax.nn.silu(c) @ w_ada[i] + b_ada[i])[:, None, :], N_MOD, axis=-1)
        mc = jnp.split(jax.nn.silu(c_ctx) @ w_ada[i] + b_ada[i], N_MOD, axis=-1)
        xl, xc = trunk_layer(xl, xc, ml, mc, norm_w[i], w_ffn1_in[i], w_ffn1_out[i],
                             w_ffn2_in[i], w_ffn2_out[i], w_in[i], q_norm_w[i], kv_norm_w[i],
                             w_uq[i], w_ukv[i], conv_w[i], w_out[i], tabs, last)
    return rmsnorm(xl, final_norm_w)
```

```cpp
#include <hip/hip_runtime.h>
#include <hip/hip_cooperative_groups.h>
#include <cstdio>
#include <cstdint>
namespace cg = cooperative_groups;

#ifndef PROBE_DUP
#define PROBE_DUP (-1)
#endif
#ifndef MK_PER_PHASE_LAUNCH
#define MK_PER_PHASE_LAUNCH 0
#endif

#define LAS __attribute__((address_space(3)))
typedef unsigned short bf16_t;
typedef short bf16x8 __attribute__((ext_vector_type(8)));
typedef float f32x4 __attribute__((ext_vector_type(4)));
typedef float f32x2 __attribute__((ext_vector_type(2)));
typedef float f32x16 __attribute__((ext_vector_type(16)));
typedef unsigned u32x4 __attribute__((ext_vector_type(4)));
typedef unsigned u32x2 __attribute__((ext_vector_type(2)));

constexpr int DM = 1024, SEQ = 8192, ML = 16384, MC = 512, MT = 16896, DFF = 2816, NFF = 5632, DIN = 1952, DINP = 2048;
constexpr int NUP = 1280, KUP = 384, NMOD = 9216;
constexpr float EPS = 1e-6f;
constexpr float C2 = 0.10206207261596577f * 1.4426950408889634f;

constexpr size_t WS_MOD = 0;
constexpr size_t WS_CNT = 229376;
constexpr size_t WS_WUP = 262144;
constexpr size_t WUP_L = 1376256, WUP_VT = 983040;
constexpr size_t ZERO_BYTES = 262144 + 2 * WUP_L;
constexpr size_t WS_ROPE = ZERO_BYTES;
constexpr size_t WS_SW = WS_ROPE + 8192;
constexpr size_t SW_L = 39936;
constexpr size_t WS_SSQP = WS_SW + 2 * SW_L * 4;
constexpr size_t WS_SSQQ = WS_SSQP + (size_t)MT * 64;
constexpr size_t WS_SSQKV = WS_SSQQ + (size_t)MT * 16;
constexpr size_t WS_W = 5242880;
constexpr size_t W_1IN = 0, W_1OUT = 11534336, W_2IN = 17301504, W_2OUT = 28835840, W_IN = 34603008, W_OUT = 38797312, W_L = 40894464;
constexpr size_t WS_XCTX = WS_W + 2 * W_L;
constexpr size_t WS_XW = WS_XCTX + (size_t)MC * DM * 4;
constexpr size_t WS_H = WS_XW + (size_t)MT * DM * 2;
constexpr size_t WS_P = WS_H, WS_KN = WS_P + (size_t)MT * DINP * 2, WS_KPE = WS_KN + (size_t)MT * 512 * 2;
constexpr size_t WS_VT = WS_H + (size_t)MT * DFF * 2;
constexpr size_t WS_MIX = WS_VT + (size_t)512 * MT * 2;
constexpr size_t WS_END = WS_MIX + (size_t)MT * DM * 2;
static_assert(WS_SSQKV + (size_t)MT * 16 <= WS_W, "small region");
static_assert(WS_KPE + (size_t)MT * 64 <= WS_VT, "overlay");

constexpr int LDS_BYTES = 131072;

typedef __bf16 bf16x2_t __attribute__((ext_vector_type(2)));
__device__ __forceinline__ unsigned cvt_pk_bf16(float lo, float hi) { const f32x2 v = {lo, hi}; return __builtin_bit_cast(unsigned, __builtin_convertvector(v, bf16x2_t)); }
__device__ __forceinline__ float bf_lo(unsigned w) { return __builtin_bit_cast(float, w << 16); }
__device__ __forceinline__ float bf_hi(unsigned w) { return __builtin_bit_cast(float, w & 0xffff0000u); }
__device__ __forceinline__ float shx(float v, int o, int lane) { return __builtin_bit_cast(float, __builtin_amdgcn_ds_bpermute((lane ^ o) << 2, __builtin_bit_cast(int, v))); }
__device__ __forceinline__ float wave_sum(float v, int lane) {
#pragma unroll
    for (int o = 1; o < 64; o <<= 1) v += shx(v, o, lane);
    return v;
}
__device__ __forceinline__ float fast_silu(float g) { return g * __builtin_amdgcn_rcpf(1.0f + __builtin_amdgcn_exp2f(-1.4426950408889634f * g)); }
__device__ __forceinline__ float sum4(f32x4 v) { return (v.x + v.y) + (v.z + v.w); }
__device__ __forceinline__ float dot4(f32x4 v) { return (v.x * v.x + v.y * v.y) + (v.z * v.z + v.w * v.w); }
__device__ __forceinline__ float quad_sum(float t, int lane) { t += shx(t, 16, lane); t += shx(t, 32, lane); return t; }

__device__ __forceinline__ int fresh_lane() { int l; asm volatile("v_mbcnt_lo_u32_b32 %0, -1, 0\n\tv_mbcnt_hi_u32_b32 %0, -1, %0" : "=v"(l)); return l; }

namespace pg8 {
constexpr int BM = 256, BK = 64, HALF = 128, HTB = HALF * BK * 2, STAGE_BYTES = 8 * HTB, NXCD = 8, WGM = 8;
__host__ __device__ __forceinline__ int lds_byte(int r, int c) { const int st = (r >> 4) * 2 + (c >> 5), rr = r & 15, cc = c & 31, ob = rr * 64 + cc * 2; return st * 1024 + (ob ^ (((ob >> 9) & 1) << 5)); }
__host__ __device__ __forceinline__ void stage_rc(int b, int& R, int& C) { const int st = b / 1024, sb = b % 1024, swz = sb ^ (((sb >> 9) & 1) << 5); R = (st >> 1) * 16 + swz / 64; C = (st & 1) * 32 + (swz % 64) / 2; }
__host__ __device__ __forceinline__ int perm32(int rho) { const int n = rho >> 4, i = rho & 15; return 8 * (i >> 2) + 4 * n + (i & 3); }

struct Unit { int pm, pn; };
struct Gemm { const bf16_t* A; const bf16_t* Bt; int M, N, K, lda, ldb; };

struct StaticOrder {
    int nM, nN, nwg, G, c, wgm, xrow;
    __device__ __forceinline__ void init(int M, int N, int G_, int c_, int wgm_ = WGM, int xrow_ = 0) { nM = M / BM; nN = N / BM; nwg = nM * nN; G = G_; c = c_; wgm = wgm_; xrow = xrow_; }
    __device__ __forceinline__ bool next(int i, Unit& u) const {
        if (xrow) {
            const int x = c & 7, j = i * 32 + (c >> 3), nlat = 8 * nN;
            if (j < nlat) { const int grp = j / (4 * nN), w = j % (4 * nN); u.pm = 8 * x + 4 * grp + (w & 3); u.pn = w >> 2; return true; }
            const int ci = (j - nlat) * 8 + x;
            if (nM <= 64 || ci >= 2 * nN) return false;
            u.pm = 64 + ci / nN; u.pn = ci % nN; return true;
        }
        const long L = (long)i * G + c; if (L >= nwg) return false;
        int wgid = (int)L; { const int q = nwg / NXCD, r = nwg % NXCD, xcd = wgid % NXCD, off = wgid / NXCD; wgid = (xcd < r ? xcd * (q + 1) : r * (q + 1) + (xcd - r) * q) + off; }
        const int nig = wgm * nN, gid = wgid / nig, fm = gid * wgm, gsz = (nM - fm) < wgm ? (nM - fm) : wgm;
        u.pm = fm + ((wgid % nig) % gsz); u.pn = (wgid % nig) / gsz; return true;
    }
};

template <class Epi>
__device__ __forceinline__ void gemm_phase(LAS unsigned char* lds, const Gemm g, const StaticOrder& S, const Epi& E, const int tid_in) {
    int tid = tid_in; asm volatile("" : "+v"(tid));
    const int wid = __builtin_amdgcn_readfirstlane(tid >> 6), lane = tid & 63, wr = wid >> 2, wc = wid & 3, fr = lane & 15, fq = lane >> 4;
    const int K = g.K, nt = K / BK;
    unsigned voffA[2], voffB[2];
#pragma unroll
    for (int i = 0; i < 2; ++i) { int R, C; stage_rc(tid * 16 + i * 8192, R, C); const int Rb = Epi::PERM ? ((R & ~31) + perm32(R & 31)) : R;
        voffA[i] = (unsigned)(R * g.lda + C) * 2u; voffB[i] = (unsigned)(Rb * g.ldb + C) * 2u; }
    const size_t kstep = (size_t)(BK * 2);
    const size_t hstepA = (size_t)HALF * g.lda * 2, hstepB = (size_t)HALF * g.ldb * 2;
    const size_t tstepA = 2 * hstepA, tstepB = 2 * hstepB;
    const unsigned ldsw = (unsigned)wid * 1024u;
    const int aoff = lds_byte(wr * 64 + fr, fq * 8), boff = lds_byte(wc * 32 + fr, fq * 8);
#define PG8_SA(b, h) (((b) * 2 + (h)) * HTB)
#define PG8_SB(b, h) ((4 + (b) * 2 + (h)) * HTB)
#define PG8_STAGE(bufoff, gbase, voff) do { _Pragma("unroll") for (int _i = 0; _i < 2; ++_i) \
        __builtin_amdgcn_global_load_lds((const unsigned*)((const char*)(gbase) + (voff)[_i]), (LAS unsigned*)(lds + (bufoff) + ldsw + _i * 8192), 16, 0, 0); } while (0)
#define PG8_LDA(dst, b, h) do { _Pragma("unroll") for (int m = 0; m < 4; ++m) _Pragma("unroll") for (int k = 0; k < 2; ++k) dst[m][k] = *(const LAS bf16x8*)(lds + PG8_SA(b, h) + aoff + m * 2048 + k * 1024); } while (0)
#define PG8_LDB(dst, b, h) do { _Pragma("unroll") for (int n = 0; n < 2; ++n) _Pragma("unroll") for (int k = 0; k < 2; ++k) dst[n][k] = *(const LAS bf16x8*)(lds + PG8_SB(b, h) + boff + n * 2048 + k * 1024); } while (0)
#define PG8_MMA(ai, bj, At, Bt) do { __builtin_amdgcn_s_setprio(1); _Pragma("unroll") for (int m = 0; m < 4; ++m) _Pragma("unroll") for (int n = 0; n < 2; ++n) _Pragma("unroll") for (int k = 0; k < 2; ++k) \
        acc[ai][bj][m][n] = __builtin_amdgcn_mfma_f32_16x16x32_bf16(Bt[n][k], At[m][k], acc[ai][bj][m][n], 0, 0, 0); __builtin_amdgcn_s_setprio(0); } while (0)
#define PG8_WAIT_V(n) asm volatile("s_waitcnt vmcnt(" #n ")" ::: "memory")
#define PG8_WAIT_L(n) asm volatile("s_waitcnt lgkmcnt(" #n ")" ::: "memory")
#define PG8_BAR __builtin_amdgcn_s_barrier()
#define PG8_SCHED __builtin_amdgcn_sched_barrier(0)
    Unit cur, nxt; int ui = 0;
    if (!S.next(0, cur)) return;
    f32x4 acc[2][2][4][2];
#pragma unroll
    for (int a = 0; a < 2; ++a)
#pragma unroll
        for (int b = 0; b < 2; ++b)
#pragma unroll
            for (int m = 0; m < 4; ++m)
#pragma unroll
                for (int n = 0; n < 2; ++n) acc[a][b][m][n] = (f32x4){0.f, 0.f, 0.f, 0.f};
    bf16x8 At[4][2], B0[2][2], B1[2][2];
    const char* cA = (const char*)g.A + (size_t)cur.pm * tstepA; const char* cB = (const char*)g.Bt + (size_t)cur.pn * tstepB;
    PG8_STAGE(PG8_SB(0, 0), cB, voffB); PG8_STAGE(PG8_SB(0, 1), cB + hstepB, voffB); PG8_STAGE(PG8_SA(0, 0), cA, voffA); PG8_STAGE(PG8_SA(0, 1), cA + hstepA, voffA);
    if (wr == 1) PG8_BAR;
    PG8_WAIT_V(2); PG8_BAR;
    PG8_STAGE(PG8_SB(1, 0), cB + kstep, voffB); PG8_STAGE(PG8_SA(1, 0), cA + kstep, voffA); PG8_STAGE(PG8_SB(1, 1), cB + hstepB + kstep, voffB);
    PG8_WAIT_V(6); PG8_BAR;
    for (;;) {
        const bool has_next = S.next(ui + 1, nxt);
        const char* nA = has_next ? (const char*)g.A + (size_t)nxt.pm * tstepA : cA; const char* nB = has_next ? (const char*)g.Bt + (size_t)nxt.pn * tstepB : cB;
        for (int t = 0; t < nt; t += 2) {
            const bool last = (t == nt - 2);
            const char* a1 = cA + (size_t)(t + 1) * kstep;
            const char* a2 = last ? nA : cA + (size_t)(t + 2) * kstep; const char* b2 = last ? nB : cB + (size_t)(t + 2) * kstep;
            const char* a3 = a2 + kstep; const char* b3 = b2 + kstep;
            PG8_LDB(B0, 0, 0); PG8_LDB(B1, 0, 1); PG8_SCHED; PG8_LDA(At, 0, 0); PG8_STAGE(PG8_SA(1, 1), a1 + hstepA, voffA);
            PG8_WAIT_V(8); PG8_WAIT_L(0); PG8_BAR; PG8_MMA(0, 0, At, B0); PG8_MMA(0, 1, At, B1); PG8_BAR; PG8_SCHED;
            PG8_LDA(At, 0, 1); PG8_STAGE(PG8_SB(0, 0), b2, voffB); PG8_STAGE(PG8_SB(0, 1), b2 + hstepB, voffB); PG8_STAGE(PG8_SA(0, 0), a2, voffA);
            PG8_WAIT_V(8); PG8_WAIT_L(0); PG8_BAR; PG8_MMA(1, 0, At, B0); PG8_MMA(1, 1, At, B1); PG8_BAR; PG8_SCHED;
            PG8_LDB(B0, 1, 0); PG8_LDB(B1, 1, 1); PG8_SCHED; PG8_LDA(At, 1, 0); PG8_STAGE(PG8_SA(0, 1), a2 + hstepA, voffA);
            PG8_WAIT_V(8); PG8_WAIT_L(0); PG8_BAR; PG8_MMA(0, 0, At, B0); PG8_MMA(0, 1, At, B1); PG8_BAR; PG8_SCHED;
            PG8_LDA(At, 1, 1); PG8_STAGE(PG8_SB(1, 0), b3, voffB); PG8_STAGE(PG8_SB(1, 1), b3 + hstepB, voffB); PG8_STAGE(PG8_SA(1, 0), a3, voffA);
            PG8_WAIT_V(8); PG8_WAIT_L(0); PG8_BAR; PG8_MMA(1, 0, At, B0); PG8_MMA(1, 1, At, B1); PG8_BAR; PG8_SCHED;
        }
        if (wr == 0) PG8_BAR;
        E(acc, cur, wr, wc, fr, fq);
        if (!has_next) break;
#pragma unroll
        for (int a = 0; a < 2; ++a)
#pragma unroll
            for (int b = 0; b < 2; ++b)
#pragma unroll
                for (int m = 0; m < 4; ++m)
#pragma unroll
                    for (int n = 0; n < 2; ++n) acc[a][b][m][n] = (f32x4){0.f, 0.f, 0.f, 0.f};
        cur = nxt; cA = nA; cB = nB; ++ui;
        if (wr == 1) PG8_BAR;
    }
    PG8_WAIT_V(0);
    PG8_BAR;
#undef PG8_SA
#undef PG8_SB
#undef PG8_STAGE
#undef PG8_LDA
#undef PG8_LDB
#undef PG8_MMA
#undef PG8_WAIT_V
#undef PG8_WAIT_L
#undef PG8_BAR
#undef PG8_SCHED
}

__device__ __forceinline__ int stream_of(int pm) { return pm < 32 ? 0 : (pm < 64 ? 1 : 2); }

__device__ __forceinline__ void rope_apply(f32x4& a, f32x4& b, const float* rope, int row, int fq) {
    const int pos = (fq >> 1) ? (row & 63) : ((row >> 6) & 127);
    const float* tp = rope + (pos * 8 + 4 * (fq & 1)) * 2;
    const f32x4 cs0 = *(const f32x4*)tp, cs1 = *(const f32x4*)(tp + 4);
    const f32x4 c = (f32x4){cs0.x, cs0.z, cs1.x, cs1.z}, s = (f32x4){cs0.y, cs0.w, cs1.y, cs1.w};
    const f32x4 o1 = a * c - b * s, o2 = b * c + a * s; a = o1; b = o2;
}

struct EpiSwiglu {
    static constexpr bool PERM = true;
    bf16_t* H; const float* ssqp; const float* sW; unsigned* cnt;
    __device__ __forceinline__ void operator()(const f32x4 (&acc)[2][2][4][2], const Unit& u, int wr, int wc, int fr, int fq) const { run<0, 2>(acc, u, wr, wc, fr, fq); }
    template <int A0, int A1> __device__ __forceinline__ void run(const f32x4 (&acc)[2][2][4][2], const Unit& u, int wr, int wc, int fr, int fq) const {
        const int s = stream_of(u.pm);
        const int cb = u.pn * 256 + wc * 32 + fq * 8;
        const float* bp = sW + s * NFF + cb;
        f32x4 bg[2], bu[2];
#pragma unroll
        for (int n = 0; n < 2; ++n) { bg[n] = *(const f32x4*)(bp + 4 * n); bu[n] = *(const f32x4*)(bp + 128 + 4 * n); }
        const int row0 = u.pm * 256 + wr * 64 + fr;
#pragma unroll
        for (int ai = A0; ai < A1; ++ai)
#pragma unroll
            for (int m = 0; m < 4; ++m) {
                const int row = row0 + ai * 128 + m * 16;
                const float t = quad_sum(sum4(*(const f32x4*)(ssqp + (size_t)row * 16 + 4 * fq)), fq * 16 + fr);
                const float rr = rsqrtf(t * (1.0f / 1024.0f) + EPS);
                u32x4 w;
#pragma unroll
                for (int n = 0; n < 2; ++n) {
                    const f32x4 gg = acc[ai][0][m][n] * rr + bg[n], uu = acc[ai][1][m][n] * rr + bu[n];
                    const float h0 = fast_silu(gg.x) * uu.x, h1 = fast_silu(gg.y) * uu.y, h2 = fast_silu(gg.z) * uu.z, h3 = fast_silu(gg.w) * uu.w;
                    w[2 * n] = cvt_pk_bf16(h0, h1); w[2 * n + 1] = cvt_pk_bf16(h2, h3);
                }
                bf16_t* hp = H + (size_t)row * DFF + u.pn * 128 + wc * 32 + fq * 8;
                if (cnt) asm volatile("global_store_dwordx4 %0, %1, off sc0 sc1" :: "v"(hp), "v"(w) : "memory");
                else *(u32x4*)hp = w;
            }
        if (cnt && A1 - A0 == 2) {
            asm volatile("s_waitcnt vmcnt(0)" ::: "memory");
            if (fr == 0 && fq == 0) __hip_atomic_fetch_add(cnt + u.pm, 1u, __ATOMIC_RELAXED, __HIP_MEMORY_SCOPE_AGENT);
        }
    }
};

struct EpiResid {
    static constexpr bool PERM = true;
    const float* xo_lat; const float* xo_ctx; float* xn_lat; float* xn_ctx;
    const float* gate; const float* nw; const float* nscale; bf16_t* Xw; float* ssqp; int full_gate; int has_next;
    __device__ __forceinline__ void operator()(const f32x4 (&acc)[2][2][4][2], const Unit& u, int wr, int wc, int fr, int fq) const { run<0, 2>(acc, u, wr, wc, fr, fq); }
    template <int A0, int A1> __device__ __forceinline__ void run(const f32x4 (&acc)[2][2][4][2], const Unit& u, int wr, int wc, int fr, int fq) const {
        const int s = stream_of(u.pm);
        const float gmul = full_gate ? 1.0f : 0.5f;
        const float* xo = (u.pm < 64) ? xo_lat : xo_ctx - (size_t)ML * DM;
        float* xn = (u.pm < 64) ? xn_lat : xn_ctx - (size_t)ML * DM;
        const int row0 = u.pm * 256 + wr * 64 + fr;
        float ssq[2][4];
#pragma unroll
        for (int ai = A0; ai < A1; ++ai)
#pragma unroll
            for (int m = 0; m < 4; ++m) ssq[ai][m] = 0.f;
#pragma unroll
        for (int bj = 0; bj < 2; ++bj) {
            const int col = u.pn * 256 + bj * 128 + wc * 32 + fq * 8;
            const f32x4 gv0 = *(const f32x4*)(gate + s * NMOD + col) * gmul, gv1 = *(const f32x4*)(gate + s * NMOD + col + 4) * gmul;
            f32x4 wv0 = (f32x4){0.f, 0.f, 0.f, 0.f}, wv1 = wv0;
            if (has_next) { wv0 = *(const f32x4*)(nw + col) * (*(const f32x4*)(nscale + s * NMOD + col) + 1.0f); wv1 = *(const f32x4*)(nw + col + 4) * (*(const f32x4*)(nscale + s * NMOD + col + 4) + 1.0f); }
#pragma unroll
            for (int ai = A0; ai < A1; ++ai)
#pragma unroll
                for (int m = 0; m < 4; ++m) {
                    const size_t off = (size_t)(row0 + ai * 128 + m * 16) * DM + col;
                    const f32x4 x0 = *(const f32x4*)(xo + off) + gv0 * acc[ai][bj][m][0];
                    const f32x4 x1 = *(const f32x4*)(xo + off + 4) + gv1 * acc[ai][bj][m][1];
                    *(f32x4*)(xn + off) = x0; *(f32x4*)(xn + off + 4) = x1;
                    ssq[ai][m] += dot4(x0) + dot4(x1);
                    if (has_next) { const f32x4 y0 = x0 * wv0, y1 = x1 * wv1; u32x4 w; w.x = cvt_pk_bf16(y0.x, y0.y); w.y = cvt_pk_bf16(y0.z, y0.w); w.z = cvt_pk_bf16(y1.x, y1.y); w.w = cvt_pk_bf16(y1.z, y1.w); *(u32x4*)(Xw + off) = w; }
                }
        }
#pragma unroll
        for (int ai = A0; ai < A1; ++ai)
#pragma unroll
            for (int m = 0; m < 4; ++m) {
                const float t = quad_sum(ssq[ai][m], fq * 16 + fr);
                if (fq == 0) ssqp[(size_t)(row0 + ai * 128 + m * 16) * 16 + u.pn * 4 + wc] = t;
            }
    }
};

struct EpiInproj {
    static constexpr bool PERM = true;
    bf16_t* P; bf16_t* KPE; const float* ssqp; const float* sW; float* ssqq; float* ssqkv; const float* rope;
    __device__ __forceinline__ void operator()(const f32x4 (&acc)[2][2][4][2], const Unit& u, int wr, int wc, int fr, int fq) const { run<0, 2>(acc, u, wr, wc, fr, fq); }
    template <int A0, int A1> __device__ __forceinline__ void run(const f32x4 (&acc)[2][2][4][2], const Unit& u, int wr, int wc, int fr, int fq) const {
        const int s = stream_of(u.pm);
        const int cb = u.pn * 256 + wc * 32 + fq * 8;
        f32x4 b[2][2];
#pragma unroll
        for (int bj = 0; bj < 2; ++bj)
#pragma unroll
            for (int n = 0; n < 2; ++n) b[bj][n] = *(const f32x4*)(sW + s * DINP + cb + bj * 128 + 4 * n);
        const int row0 = u.pm * 256 + wr * 64 + fr;
#pragma unroll
        for (int ai = A0; ai < A1; ++ai)
#pragma unroll
            for (int m = 0; m < 4; ++m) {
                const int row = row0 + ai * 128 + m * 16;
                const float t = quad_sum(sum4(*(const f32x4*)(ssqp + (size_t)row * 16 + 4 * fq)), fq * 16 + fr);
                const float rr = rsqrtf(t * (1.0f / 1024.0f) + EPS);
                f32x4 v[2][2];
#pragma unroll
                for (int bj = 0; bj < 2; ++bj)
#pragma unroll
                    for (int n = 0; n < 2; ++n) v[bj][n] = acc[ai][bj][m][n] * rr + b[bj][n];
                if (u.pn == 0) {
                    const float q = quad_sum((dot4(v[0][0]) + dot4(v[0][1])) + (dot4(v[1][0]) + dot4(v[1][1])), fq * 16 + fr);
                    if (fq == 0) ssqq[(size_t)row * 4 + wc] = q;
                } else if (u.pn == 1) {
                    const float q = quad_sum(dot4(v[0][0]) + dot4(v[0][1]), fq * 16 + fr);
                    if (fq == 0) ssqkv[(size_t)row * 4 + wc] = q;
                }
#pragma unroll
                for (int bj = 0; bj < 2; ++bj) {
                    u32x4 w; w.x = cvt_pk_bf16(v[bj][0].x, v[bj][0].y); w.y = cvt_pk_bf16(v[bj][0].z, v[bj][0].w); w.z = cvt_pk_bf16(v[bj][1].x, v[bj][1].y); w.w = cvt_pk_bf16(v[bj][1].z, v[bj][1].w);
                    *(u32x4*)(P + (size_t)row * DINP + cb + bj * 128) = w;
                }
                if (u.pn == 1 && wc == 0) {
                    f32x4 a = v[1][0], bb = v[1][1];
                    if (u.pm < 64) rope_apply(a, bb, rope, row, fq);
                    u32x4 w; w.x = cvt_pk_bf16(a.x, a.y); w.y = cvt_pk_bf16(a.z, a.w); w.z = cvt_pk_bf16(bb.x, bb.y); w.w = cvt_pk_bf16(bb.z, bb.w);
                    *(u32x4*)(KPE + (size_t)row * 32 + fq * 8) = w;
                }
            }
    }
};

struct EpiUpQK {
    static constexpr bool PERM = true;
    bf16_t* Q; bf16_t* KN; const float* ssqq; const float* ssqkv; const float* rope;
    __device__ __forceinline__ void operator()(const f32x4 (&acc)[2][2][4][2], const Unit& u, int wr, int wc, int fr, int fq) const { run<0, 2>(acc, u, wr, wc, fr, fq); }
    template <int A0, int A1> __device__ __forceinline__ void run(const f32x4 (&acc)[2][2][4][2], const Unit& u, int wr, int wc, int fr, int fq) const {
        const bool isq = u.pn < 3;
        const int row0 = u.pm * 256 + wr * 64 + fr;
#pragma unroll
        for (int ai = A0; ai < A1; ++ai)
#pragma unroll
            for (int m = 0; m < 4; ++m) {
                const int row = row0 + ai * 128 + m * 16;
                const f32x4 pv = isq ? *(const f32x4*)(ssqq + (size_t)row * 4) : *(const f32x4*)(ssqkv + (size_t)row * 4);
                const float rr = isq ? rsqrtf(sum4(pv) * (1.0f / 256.0f) + EPS) * C2 : rsqrtf(sum4(pv) * (1.0f / 128.0f) + EPS);
#pragma unroll
                for (int bj = 0; bj < 2; ++bj) {
                    const int cbase = u.pn * 256 + bj * 128 + wc * 32;
                    f32x4 v0 = acc[ai][bj][m][0] * rr, v1 = acc[ai][bj][m][1] * rr;
                    if (isq && ((cbase >> 5) % 3) == 2 && u.pm < 64) rope_apply(v0, v1, rope, row, fq);
                    u32x4 w; w.x = cvt_pk_bf16(v0.x, v0.y); w.y = cvt_pk_bf16(v0.z, v0.w); w.z = cvt_pk_bf16(v1.x, v1.y); w.w = cvt_pk_bf16(v1.z, v1.w);
                    if (isq) *(u32x4*)(Q + (size_t)row * 768 + cbase + fq * 8) = w;
                    else *(u32x4*)(KN + (size_t)row * 512 + (cbase - 768) + fq * 8) = w;
                }
            }
    }
};

struct EpiVT {
    static constexpr bool PERM = true;
    bf16_t* VT; const float* ssqkv;
    __device__ __forceinline__ void operator()(const f32x4 (&acc)[2][2][4][2], const Unit& u, int wr, int wc, int fr, int fq) const { run<0, 2>(acc, u, wr, wc, fr, fq); }
    template <int A0, int A1> __device__ __forceinline__ void run(const f32x4 (&acc)[2][2][4][2], const Unit& u, int wr, int wc, int fr, int fq) const {
        f32x4 rr[2][2];
#pragma unroll
        for (int bj = 0; bj < 2; ++bj)
#pragma unroll
            for (int n = 0; n < 2; ++n) {
                const int tok0 = u.pn * 256 + bj * 128 + wc * 32 + fq * 8 + n * 4;
#pragma unroll
                for (int j = 0; j < 4; ++j) rr[bj][n][j] = rsqrtf(sum4(*(const f32x4*)(ssqkv + (size_t)(tok0 + j) * 4)) * (1.0f / 128.0f) + EPS);
            }
        const int drow0 = u.pm * 256 + wr * 64 + fr;
#pragma unroll
        for (int ai = A0; ai < A1; ++ai)
#pragma unroll
            for (int m = 0; m < 4; ++m) {
                const int drow = drow0 + ai * 128 + m * 16;
#pragma unroll
                for (int bj = 0; bj < 2; ++bj) {
                    const f32x4 v0 = acc[ai][bj][m][0] * rr[bj][0], v1 = acc[ai][bj][m][1] * rr[bj][1];
                    u32x4 w; w.x = cvt_pk_bf16(v0.x, v0.y); w.y = cvt_pk_bf16(v0.z, v0.w); w.z = cvt_pk_bf16(v1.x, v1.y); w.w = cvt_pk_bf16(v1.z, v1.w);
                    *(u32x4*)(VT + (size_t)drow * MT + u.pn * 256 + bj * 128 + wc * 32 + fq * 8) = w;
                }
            }
    }
};

template <class Epi, int AI>
__device__ __forceinline__ void skinny_item(LAS unsigned char* lds, const Gemm g, const Epi& E, const Unit u, int wr, int wc, int wave, int lane) {
    const int fr = lane & 15, fq = lane >> 4;
    f32x4 acc[2][2][4][2];
#pragma unroll
    for (int b = 0; b < 2; ++b)
#pragma unroll
        for (int m = 0; m < 4; ++m)
#pragma unroll
            for (int n = 0; n < 2; ++n) acc[AI][b][m][n] = (f32x4){0.f, 0.f, 0.f, 0.f};
    const bf16_t* pa = g.A + (size_t)(u.pm * 256 + AI * 128 + wr * 64 + fr) * g.lda + fq * 8;
    const bf16_t* pb0 = g.Bt + (size_t)(u.pn * 256 + wc * 32 + (Epi::PERM ? perm32(fr) : fr)) * g.ldb + fq * 8;
    const bf16_t* pb1 = g.Bt + (size_t)(u.pn * 256 + wc * 32 + (Epi::PERM ? perm32(16 + fr) : 16 + fr)) * g.ldb + fq * 8;
    const size_t as = (size_t)16 * g.lda, bs = (size_t)128 * g.ldb;
    const int nch = g.K >> 7, kbeg = ((wave * nch) >> 3) << 7, kend = (((wave + 1) * nch) >> 3) << 7;
    bf16x8 a0[2][4], b0[2][2][2], a1[2][4], b1[2][2][2];
#define SK_LOAD(A_, B_, kb) do { _Pragma("unroll") for (int kk = 0; kk < 2; ++kk) { \
        _Pragma("unroll") for (int m = 0; m < 4; ++m) A_[kk][m] = *(const bf16x8*)(pa + m * as + (kb) + 32 * kk); \
        _Pragma("unroll") for (int bj = 0; bj < 2; ++bj) { B_[kk][bj][0] = *(const bf16x8*)(pb0 + bj * bs + (kb) + 32 * kk); B_[kk][bj][1] = *(const bf16x8*)(pb1 + bj * bs + (kb) + 32 * kk); } } } while (0)
#define SK_MMA(A_, B_) do { _Pragma("unroll") for (int kk = 0; kk < 2; ++kk) _Pragma("unroll") for (int bj = 0; bj < 2; ++bj) _Pragma("unroll") for (int m = 0; m < 4; ++m) _Pragma("unroll") for (int n = 0; n < 2; ++n) \
        acc[AI][bj][m][n] = __builtin_amdgcn_mfma_f32_16x16x32_bf16(B_[kk][bj][n], A_[kk][m], acc[AI][bj][m][n], 0, 0, 0); } while (0)
#pragma unroll 1
    for (int k = kbeg; k < kend; k += 128) {
        SK_LOAD(a0, b0, k);
        SK_LOAD(a1, b1, k + 64);
        SK_MMA(a0, b0);
        SK_MMA(a1, b1);
    }
#undef SK_LOAD
#undef SK_MMA
    if (wave > 0) {
#pragma unroll
        for (int bj = 0; bj < 2; ++bj)
#pragma unroll
            for (int m = 0; m < 4; ++m)
#pragma unroll
                for (int n = 0; n < 2; ++n) *(LAS f32x4*)(lds + (((wave - 1) * 16 + bj * 8 + m * 2 + n) * 64 + lane) * 16) = acc[AI][bj][m][n];
    }
    __syncthreads();
    if (wave == 0) {
#pragma unroll 1
        for (int w = 0; w < 7; ++w) {
#pragma unroll
            for (int bj = 0; bj < 2; ++bj)
#pragma unroll
                for (int m = 0; m < 4; ++m)
#pragma unroll
                    for (int n = 0; n < 2; ++n) acc[AI][bj][m][n] += *(const LAS f32x4*)(lds + ((w * 16 + bj * 8 + m * 2 + n) * 64 + lane) * 16);
        }
        E.template run<AI, AI + 1>(acc, u, wr, wc, fr, fq);
    }
    __syncthreads();
}
template <class Epi>
__device__ __forceinline__ void skinny_ctx(LAS unsigned char* lds, const Gemm g, const Epi& E, int nN, int first, int stride, int wave, int lane) {
    const int nitems = 2 * nN * 16;
    for (int it = first; it < nitems; it += stride) {
        const int un = it >> 4, sub = it & 15;
        Unit u; u.pm = 64 + (un & 1); u.pn = un >> 1;
        const int wr = (sub >> 2) & 1, wc = sub & 3;
        if (sub & 8) skinny_item<Epi, 1>(lds, g, E, u, wr, wc, wave, lane); else skinny_item<Epi, 0>(lds, g, E, u, wr, wc, wave, lane);
    }
}
}

constexpr int KROW = 208, VROW = 144, KBUF = 64 * KROW, VBUF = 64 * VROW;
__device__ __forceinline__ float max2f(float a, float b) { return __builtin_fmaxf(a, b); }
__device__ __forceinline__ float max3f(float a, float b, float c) { float r; asm("v_max3_f32 %0, %1, %2, %3" : "=v"(r) : "v"(a), "v"(b), "v"(c)); return r; }
__device__ __forceinline__ float xhalf_max(float m) { auto rr = __builtin_amdgcn_permlane32_swap(__float_as_uint(m), __float_as_uint(m), false, false); return max2f(__uint_as_float(rr[0]), __uint_as_float(rr[1])); }
__device__ __forceinline__ float xhalf_sum(float m) { auto rr = __builtin_amdgcn_permlane32_swap(__float_as_uint(m), __float_as_uint(m), false, false); return __uint_as_float(rr[0]) + __uint_as_float(rr[1]); }

__device__ __forceinline__ void attn_unit(LAS unsigned char* lds, const bf16_t* __restrict__ Q, const bf16_t* __restrict__ KN, const bf16_t* __restrict__ KPE,
                                          const bf16_t* __restrict__ VT, bf16_t* __restrict__ MIX, int b, int h, int qrow0, int ntiles, const int tid_in) {
    int tid = tid_in; asm volatile("" : "+v"(tid));
    const int lane = tid & 63, r32 = lane & 31, hi = lane >> 5, wid = __builtin_amdgcn_readfirstlane(tid >> 6);
    const bf16_t* qp = Q + (size_t)(qrow0 + wid * 32 + r32) * 768 + h * 96 + hi * 8;
    bf16x8 qf[6];
#pragma unroll
    for (int ds = 0; ds < 6; ++ds) qf[ds] = *(const bf16x8*)(qp + ds * 16);
    const int kkey = tid >> 3, kc = tid & 7, pkey = (tid >> 2) & 63, pc = tid & 3;
    const bf16_t* knp = KN + (size_t)kkey * 512 + h * 64 + kc * 8;
    const bf16_t* kpp = KPE + (size_t)pkey * 32 + pc * 8;
    const bf16_t* vtp = VT + (size_t)(h * 64 + kkey) * MT + kc * 8;
    const int kw_off = kkey * KROW + kc * 16, pw_off = pkey * KROW + 128 + pc * 16, vw_off = KBUF + kkey * VROW + kc * 16;
    const int pi = (r32 & 0x13) | ((r32 & 4) << 1) | ((r32 & 8) >> 1);
    const int ka_off = pi * KROW + hi * 16, va_off = KBUF + r32 * VROW + hi * 16;
    constexpr int SLOT = KBUF + VBUF;
    u32x4 gk, gp, gv;
    gp = (u32x4){0u, 0u, 0u, 0u};
    bf16x8 kf[12], vf[8];
#define ROWBASE(kt) ((kt) < 4 ? (ML + 256 * b + 64 * (kt)) : (SEQ * b + 64 * ((kt) - 4)))
#define LOADT(kt) do { const int rb_ = ROWBASE(kt); gk = *(const u32x4*)(knp + (size_t)rb_ * 512); if (tid < 256) gp = *(const u32x4*)(kpp + (size_t)rb_ * 32); gv = *(const u32x4*)(vtp + rb_); } while (0)
#define STORET(so) do { *(LAS u32x4*)(lds + (so) + kw_off) = gk; if (tid < 256) *(LAS u32x4*)(lds + (so) + pw_off) = gp; *(LAS u32x4*)(lds + (so) + vw_off) = gv; } while (0)
#define LDK(so) do { _Pragma("unroll") for (int ds = 0; ds < 6; ++ds) { kf[2 * ds] = *(const LAS bf16x8*)(lds + (so) + ka_off + ds * 32); kf[2 * ds + 1] = *(const LAS bf16x8*)(lds + (so) + ka_off + 32 * KROW + ds * 32); } } while (0)
#define LDV(so) do { _Pragma("unroll") for (int st = 0; st < 4; ++st) { vf[2 * st] = *(const LAS bf16x8*)(lds + (so) + va_off + st * 32); vf[2 * st + 1] = *(const LAS bf16x8*)(lds + (so) + va_off + 32 * VROW + st * 32); } } while (0)
    LOADT(0); STORET(0);
    LOADT(1); STORET(SLOT);
    __syncthreads();
    LDK(0);
    int sc = 0, sn = SLOT, snn = 2 * SLOT;
    f32x16 o0 = {}, o1 = {}, o2 = {}, negm = {};
    float mref = 0.f;
    const short one_b = (r32 == 0) ? (short)0x3f80 : (short)0;
    const bf16x8 ones = (bf16x8){one_b, one_b, one_b, one_b, one_b, one_b, one_b, one_b};
    for (int t = 0; t < ntiles; ++t) {
        if (t + 2 < ntiles) LOADT(t + 2);
        LDV(sc);
        __builtin_amdgcn_sched_barrier(0);
        f32x16 s0 = negm, s1 = negm;
#pragma unroll
        for (int ds = 0; ds < 6; ++ds) {
            s0 = __builtin_amdgcn_mfma_f32_32x32x16_bf16(kf[2 * ds], qf[ds], s0, 0, 0, 0);
            s1 = __builtin_amdgcn_mfma_f32_32x32x16_bf16(kf[2 * ds + 1], qf[ds], s1, 0, 0, 0);
        }
        __builtin_amdgcn_sched_barrier(0);
        float m4[4];
#pragma unroll
        for (int c = 0; c < 4; ++c) m4[c] = max2f(s0[c], s1[c]);
#pragma unroll
        for (int r = 4; r < 16; ++r) m4[r & 3] = max2f(max2f(m4[r & 3], s0[r]), s1[r]);
        float mx = max2f(max2f(m4[0], m4[1]), max2f(m4[2], m4[3]));
        mx = xhalf_max(mx);
        if (t == 0 || __any(mx > 8.0f)) {
            const float d = (t == 0) ? mx : max2f(mx, 0.f);
            mref += d;
#pragma unroll
            for (int r = 0; r < 16; ++r) { s0[r] -= d; s1[r] -= d; negm[r] = -mref; }
            const float f = (t == 0) ? 1.0f : __builtin_amdgcn_exp2f(-d);
            o2[0] *= f;
#pragma unroll
            for (int r = 0; r < 16; ++r) { o0[r] *= f; o1[r] *= f; }
        }
#pragma unroll
        for (int r = 0; r < 16; ++r) { s0[r] = __builtin_amdgcn_exp2f(s0[r]); s1[r] = __builtin_amdgcn_exp2f(s1[r]); }
        u32x4 pw[4];
#pragma unroll
        for (int j = 0; j < 4; ++j) { pw[0][j] = cvt_pk_bf16(s0[2 * j], s0[2 * j + 1]); pw[1][j] = cvt_pk_bf16(s0[8 + 2 * j], s0[8 + 2 * j + 1]);
                                      pw[2][j] = cvt_pk_bf16(s1[2 * j], s1[2 * j + 1]); pw[3][j] = cvt_pk_bf16(s1[8 + 2 * j], s1[8 + 2 * j + 1]); }
        __builtin_amdgcn_sched_barrier(0);
        if (t + 1 < ntiles) LDK(sn);
#pragma unroll
        for (int st = 0; st < 4; ++st) {
            const bf16x8 pf = __builtin_bit_cast(bf16x8, pw[st]);
            o0 = __builtin_amdgcn_mfma_f32_32x32x16_bf16(vf[2 * st], pf, o0, 0, 0, 0);
            o1 = __builtin_amdgcn_mfma_f32_32x32x16_bf16(vf[2 * st + 1], pf, o1, 0, 0, 0);
            o2 = __builtin_amdgcn_mfma_f32_32x32x16_bf16(ones, pf, o2, 0, 0, 0);
        }
        __builtin_amdgcn_sched_barrier(0);
        if (t + 2 < ntiles) STORET(snn);
        __syncthreads();
        { const int tmp = sc; sc = sn; sn = snn; snn = tmp; }
    }
#undef ROWBASE
#undef LOADT
#undef STORET
#undef LDK
#undef LDV
    const float inv = __builtin_amdgcn_rcpf(xhalf_sum(hi == 0 ? o2[0] : 0.f));
    bf16_t* op = MIX + (size_t)(qrow0 + wid * 32 + r32) * DM + h * 64 + 4 * hi;
#pragma unroll
    for (int g = 0; g < 4; ++g) {
        u32x2 w0, w1;
        w0.x = cvt_pk_bf16(o0[4 * g] * inv, o0[4 * g + 1] * inv); w0.y = cvt_pk_bf16(o0[4 * g + 2] * inv, o0[4 * g + 3] * inv);
        w1.x = cvt_pk_bf16(o1[4 * g] * inv, o1[4 * g + 1] * inv); w1.y = cvt_pk_bf16(o1[4 * g + 2] * inv, o1[4 * g + 3] * inv);
        *(u32x2*)(op + 8 * g) = w0; *(u32x2*)(op + 32 + 8 * g) = w1;
    }
}

__device__ __forceinline__ void attn_unit2(LAS unsigned char* lds, const bf16_t* __restrict__ Q, const bf16_t* __restrict__ KN, const bf16_t* __restrict__ KPE,
                                           const bf16_t* __restrict__ VT, bf16_t* __restrict__ MIX, int b, int h, int qrow0, int ntiles, const int tid_in) {
    int tid = tid_in; asm volatile("" : "+v"(tid));
    const int lane = tid & 63, r32 = lane & 31, hi = lane >> 5, wid = __builtin_amdgcn_readfirstlane(tid >> 6);
    const bf16_t* qp = Q + (size_t)(qrow0 + wid * 64 + r32) * 768 + h * 96 + hi * 8;
    bf16x8 qa[6], qb[6];
#pragma unroll
    for (int ds = 0; ds < 6; ++ds) { qa[ds] = *(const bf16x8*)(qp + ds * 16); qb[ds] = *(const bf16x8*)(qp + (size_t)32 * 768 + ds * 16); }
    const int pi = (r32 & 0x13) | ((r32 & 4) << 1) | ((r32 & 8) >> 1);
    const int ka_off = pi * KROW + hi * 16, va_off = KBUF + r32 * VROW + hi * 16;
    constexpr int SLOT = KBUF + VBUF;
    const char* dsrc[3]; unsigned dmul[3]; int dlds[3];
#pragma unroll
    for (int r = 0; r < 3; ++r) {
        const int ii = wid + 8 * r;
        if (ii < 13) {
            const int p = 64 * ii + lane, row = p / 13, cc = p % 13;
            if (cc >= 8 && cc < 12) { dsrc[r] = (const char*)(KPE + (size_t)row * 32 + 8 * (cc - 8)); dmul[r] = 64u; }
            else { dsrc[r] = (const char*)(KN + (size_t)row * 512 + h * 64 + 8 * (cc == 12 ? 0 : cc)); dmul[r] = 1024u; }
            dlds[r] = 1024 * ii;
        } else {
            const int p = 64 * (ii - 13) + lane, d = p / 9, cc = p % 9;
            dsrc[r] = (const char*)(VT + (size_t)(h * 64 + (d < 64 ? d : 63)) * MT + 8 * (cc == 8 ? 0 : cc)); dmul[r] = 2u;
            dlds[r] = KBUF + 1024 * (ii - 13);
        }
    }
#define ROWBASE(kt) ((kt) < 4 ? (ML + 256 * b + 64 * (kt)) : (SEQ * b + 64 * ((kt) - 4)))
#define DMAT(kt, so) do { const unsigned rb_ = (unsigned)ROWBASE(kt); _Pragma("unroll") for (int r = 0; r < 3; ++r) if (wid + 8 * r < 22) \
        __builtin_amdgcn_global_load_lds((const unsigned*)(dsrc[r] + (size_t)rb_ * dmul[r]), (LAS unsigned*)(lds + (so) + dlds[r]), 16, 0, 0); } while (0)
    DMAT(0, 0);
    DMAT(1, SLOT);
    __syncthreads();
    int sc = 0, sn = SLOT, snn = 2 * SLOT;
    f32x16 oa0 = {}, oa1 = {}, ob0 = {}, ob1 = {};
    float ma = -1.0e30f, mb = -1.0e30f, la = 0.f, lb = 0.f;
    for (int t = 0; t < ntiles; ++t) {
        __builtin_amdgcn_sched_barrier(0);
        f32x16 sa0 = {}, sa1 = {}, sb0 = {}, sb1 = {};
        const LAS unsigned char* ka = lds + sc + ka_off;
#pragma unroll
        for (int ds = 0; ds < 6; ++ds) {
            const bf16x8 k0 = *(const LAS bf16x8*)(ka + ds * 32);
            const bf16x8 k1 = *(const LAS bf16x8*)(ka + 32 * KROW + ds * 32);
            sa0 = __builtin_amdgcn_mfma_f32_32x32x16_bf16(k0, qa[ds], sa0, 0, 0, 0);
            sa1 = __builtin_amdgcn_mfma_f32_32x32x16_bf16(k1, qa[ds], sa1, 0, 0, 0);
            sb0 = __builtin_amdgcn_mfma_f32_32x32x16_bf16(k0, qb[ds], sb0, 0, 0, 0);
            sb1 = __builtin_amdgcn_mfma_f32_32x32x16_bf16(k1, qb[ds], sb1, 0, 0, 0);
        }
        __builtin_amdgcn_sched_barrier(0);
        if (t + 2 < ntiles) DMAT(t + 2, snn);
        u32x4 pa[4], pb[4];
#define SOFTMAX2(S0, S1, MREF, LSUM, O0, O1, PW) do { \
        float m4[4]; \
        _Pragma("unroll") for (int c = 0; c < 4; ++c) m4[c] = max2f(S0[c], S1[c]); \
        _Pragma("unroll") for (int r = 4; r < 16; ++r) m4[r & 3] = max2f(max2f(m4[r & 3], S0[r]), S1[r]); \
        float mx = xhalf_max(max2f(max2f(m4[0], m4[1]), max2f(m4[2], m4[3]))); \
        if (__any(mx - MREF > 8.0f)) { \
            const float mnew = max2f(mx, MREF); \
            const float f = __builtin_amdgcn_exp2f(MREF - mnew); \
            MREF = mnew; LSUM *= f; \
            _Pragma("unroll") for (int r = 0; r < 16; ++r) { O0[r] *= f; O1[r] *= f; } \
        } \
        float ps = 0.f; \
        _Pragma("unroll") for (int r = 0; r < 16; ++r) { S0[r] = __builtin_amdgcn_exp2f(S0[r] - MREF); S1[r] = __builtin_amdgcn_exp2f(S1[r] - MREF); ps += S0[r] + S1[r]; } \
        LSUM += ps; \
        _Pragma("unroll") for (int j = 0; j < 4; ++j) { PW[0][j] = cvt_pk_bf16(S0[2 * j], S0[2 * j + 1]); PW[1][j] = cvt_pk_bf16(S0[8 + 2 * j], S0[8 + 2 * j + 1]); \
                                                        PW[2][j] = cvt_pk_bf16(S1[2 * j], S1[2 * j + 1]); PW[3][j] = cvt_pk_bf16(S1[8 + 2 * j], S1[8 + 2 * j + 1]); } \
    } while (0)
        SOFTMAX2(sa0, sa1, ma, la, oa0, oa1, pa);
        SOFTMAX2(sb0, sb1, mb, lb, ob0, ob1, pb);
#undef SOFTMAX2
        const LAS unsigned char* va = lds + sc + va_off;
#pragma unroll
        for (int st = 0; st < 4; ++st) {
            const bf16x8 v0 = *(const LAS bf16x8*)(va + st * 32);
            const bf16x8 v1 = *(const LAS bf16x8*)(va + 32 * VROW + st * 32);
            const bf16x8 fa = __builtin_bit_cast(bf16x8, pa[st]), fb = __builtin_bit_cast(bf16x8, pb[st]);
            oa0 = __builtin_amdgcn_mfma_f32_32x32x16_bf16(v0, fa, oa0, 0, 0, 0);
            oa1 = __builtin_amdgcn_mfma_f32_32x32x16_bf16(v1, fa, oa1, 0, 0, 0);
            ob0 = __builtin_amdgcn_mfma_f32_32x32x16_bf16(v0, fb, ob0, 0, 0, 0);
            ob1 = __builtin_amdgcn_mfma_f32_32x32x16_bf16(v1, fb, ob1, 0, 0, 0);
        }
        __builtin_amdgcn_sched_barrier(0);
        __syncthreads();
        { const int tmp = sc; sc = sn; sn = snn; snn = tmp; }
    }
#undef ROWBASE
#undef DMAT
    const float inva = __builtin_amdgcn_rcpf(xhalf_sum(la)), invb = __builtin_amdgcn_rcpf(xhalf_sum(lb));
    bf16_t* op = MIX + (size_t)(qrow0 + wid * 64 + r32) * DM + h * 64 + 4 * hi;
#pragma unroll
    for (int g = 0; g < 4; ++g) {
        u32x2 w0, w1;
        w0.x = cvt_pk_bf16(oa0[4 * g] * inva, oa0[4 * g + 1] * inva); w0.y = cvt_pk_bf16(oa0[4 * g + 2] * inva, oa0[4 * g + 3] * inva);
        w1.x = cvt_pk_bf16(oa1[4 * g] * inva, oa1[4 * g + 1] * inva); w1.y = cvt_pk_bf16(oa1[4 * g + 2] * inva, oa1[4 * g + 3] * inva);
        *(u32x2*)(op + 8 * g) = w0; *(u32x2*)(op + 32 + 8 * g) = w1;
        w0.x = cvt_pk_bf16(ob0[4 * g] * invb, ob0[4 * g + 1] * invb); w0.y = cvt_pk_bf16(ob0[4 * g + 2] * invb, ob0[4 * g + 3] * invb);
        w1.x = cvt_pk_bf16(ob1[4 * g] * invb, ob1[4 * g + 1] * invb); w1.y = cvt_pk_bf16(ob1[4 * g + 2] * invb, ob1[4 * g + 3] * invb);
        *(u32x2*)(op + (size_t)32 * DM + 8 * g) = w0; *(u32x2*)(op + (size_t)32 * DM + 32 + 8 * g) = w1;
    }
}

enum { MAP_ID = 0, MAP_SWIGLU, MAP_WIN, MAP_UPQ, MAP_UPK, MAP_VT };
__device__ __forceinline__ int lmap(int p) { const int fq = p >> 3, nn = (p >> 2) & 1, j = p & 3; return 16 * (fq >> 1) + 8 * nn + 4 * (fq & 1) + j; }
template <int MAP> __device__ __forceinline__ int map_col(int n) {
    if (MAP == MAP_ID) return n;
    if (MAP == MAP_SWIGLU) { const int t = n >> 8, bj = (n >> 7) & 1, i = n & 127; return bj * DFF + 128 * t + i; }
    if (MAP == MAP_WIN) { if (n >= DIN) return -1; if (n >= 384 && n < 416) return 384 + lmap(n - 384); return n; }
    if (MAP == MAP_UPQ) { const int hh = n / 96, r = n % 96; return r < 64 ? n : hh * 96 + 64 + lmap(r - 64); }
    if (MAP == MAP_UPK) return (n >> 6) * 128 + (n & 63);
    return (n >> 6) * 128 + 64 + (n & 63);
}
template <int MAP> __device__ __forceinline__ void tr_item(const float* __restrict__ W, int Nsrc, const float* __restrict__ kscale, bf16_t* __restrict__ dst, int ldd, int kdst0, int nblk,
                                                           LAS float* scr, int item, int lane) {
    const int kb = item / nblk, nb = item % nblk, k0 = 64 * kb, n0 = 32 * nb;
    const int q4 = lane & 7, kr = lane >> 3;
    const int src = map_col<MAP>(n0 + 4 * q4);
    f32x4 tv[8];
#pragma unroll
    for (int i = 0; i < 8; ++i) { const int kk = 8 * i + kr; tv[i] = (src >= 0) ? *(const f32x4*)(W + (size_t)(k0 + kk) * Nsrc + src) : (f32x4){0.f, 0.f, 0.f, 0.f}; }
#pragma unroll
    for (int i = 0; i < 8; ++i) { const int kk = 8 * i + kr; f32x4 v = tv[i]; if (kscale) v = v * kscale[k0 + kk];
        scr[kk * 33 + 4 * q4 + 0] = v.x; scr[kk * 33 + 4 * q4 + 1] = v.y; scr[kk * 33 + 4 * q4 + 2] = v.z; scr[kk * 33 + 4 * q4 + 3] = v.w; }
    asm volatile("s_waitcnt lgkmcnt(0)" ::: "memory");
    const int c = lane & 7;
#pragma unroll
    for (int j = 0; j < 4; ++j) { const int n = (lane >> 3) + 8 * j; const LAS float* s = scr + (8 * c) * 33 + n;
        u32x4 o; o.x = cvt_pk_bf16(s[0 * 33], s[1 * 33]); o.y = cvt_pk_bf16(s[2 * 33], s[3 * 33]); o.z = cvt_pk_bf16(s[4 * 33], s[5 * 33]); o.w = cvt_pk_bf16(s[6 * 33], s[7 * 33]);
        *(u32x4*)(dst + (size_t)(n0 + n) * ldd + kdst0 + k0 + 8 * c) = o; }
    asm volatile("s_waitcnt lgkmcnt(0)" ::: "memory");
}

struct Args { const float* in[19]; float* out; unsigned char* ws; int ph_lo, ph_hi; };

__global__ void __launch_bounds__(512, 2) mega_fwd(Args a_byval) {
    extern __shared__ __attribute__((aligned(16))) unsigned char lds_raw[];
    cg::grid_group grid = cg::this_grid();
    const int ph_lo = a_byval.ph_lo, ph_hi = a_byval.ph_hi;
    const int wave0 = __builtin_amdgcn_readfirstlane((int)threadIdx.x >> 6);
    const int it_hi = ph_hi + (PROBE_DUP >= 0 ? 1 : 0);
    for (int it = ph_lo; it < it_hi; ++it) {
    const int ph = (PROBE_DUP >= 0 && it > PROBE_DUP) ? it - 1 : it;
    const __attribute__((address_space(4))) unsigned char* kap = (const __attribute__((address_space(4))) unsigned char*)__builtin_amdgcn_kernarg_segment_ptr();
    asm volatile("" : "+s"(kap));
    const __attribute__((address_space(4))) Args& a = *(const __attribute__((address_space(4))) Args*)kap;
    LAS unsigned char* lds = (LAS unsigned char*)lds_raw;
    const int wave = wave0;
    int G = gridDim.x, bx = blockIdx.x; asm volatile("" : "+s"(G), "+s"(bx));
    const int vcu = (G % 8 == 0) ? (bx % 8) * (G / 8) + bx / 8 : bx;
    const int gw = vcu * 8 + wave, NGW = G * 8;
    const int gwm = wave * G + vcu;
    unsigned char* ws = a.ws;
    float* mod = (float*)(ws + WS_MOD);
    float* rope = (float*)(ws + WS_ROPE);
    float* sWall = (float*)(ws + WS_SW);
    float* ssqp = (float*)(ws + WS_SSQP);
    float* ssqq = (float*)(ws + WS_SSQQ);
    float* ssqkv = (float*)(ws + WS_SSQKV);
    float* xctx = (float*)(ws + WS_XCTX);
    bf16_t* Xw = (bf16_t*)(ws + WS_XW);
    bf16_t* Qb = (bf16_t*)(ws + WS_XW);
    bf16_t* Hb = (bf16_t*)(ws + WS_H);
    bf16_t* Pb = (bf16_t*)(ws + WS_P);
    bf16_t* KNb = (bf16_t*)(ws + WS_KN);
    bf16_t* KPEb = (bf16_t*)(ws + WS_KPE);
    bf16_t* VTb = (bf16_t*)(ws + WS_VT);
    bf16_t* MIXb = (bf16_t*)(ws + WS_MIX);
    const float* x_in = a.in[0]; const float* ctx_in = a.in[2];
    const float* norm_w = a.in[6];
    {
        if (ph == 0) {
            const int lane = fresh_lane(); const int tid = wave0 * 64 + lane; (void)tid; (void)lane;
            LAS float* scr = (LAS float*)(lds + wave * 16384);
            constexpr int I1 = 2816, I2 = 1408, I5 = 1024, I6 = 96, I8 = 32, I12 = 512;
            constexpr int PER_L = 2 * I1 + 2 * I2 + I5 + I6 + 2 * I8 + I12;
            constexpr int N_TR = 2 * PER_L, N_ADA = 2 * 144 * 8, N_ALL = N_TR + N_ADA + 1;
            for (int it = gw; it < N_ALL; it += NGW) {
                if (it < N_TR) {
                    const int l = it / PER_L; int r = it % PER_L;
                    unsigned char* wl = ws + WS_W + (size_t)l * W_L;
                    unsigned char* wu = ws + WS_WUP + (size_t)l * WUP_L;
                    if (r < I1) { tr_item<MAP_SWIGLU>(a.in[7] + (size_t)l * DM * NFF, NFF, nullptr, (bf16_t*)(wl + W_1IN), DM, 0, NFF / 32, scr, r, lane); continue; } r -= I1;
                    if (r < I2) { tr_item<MAP_ID>(a.in[8] + (size_t)l * DFF * DM, DM, nullptr, (bf16_t*)(wl + W_1OUT), DFF, 0, DM / 32, scr, r, lane); continue; } r -= I2;
                    if (r < I1) { tr_item<MAP_SWIGLU>(a.in[9] + (size_t)l * DM * NFF, NFF, nullptr, (bf16_t*)(wl + W_2IN), DM, 0, NFF / 32, scr, r, lane); continue; } r -= I1;
                    if (r < I2) { tr_item<MAP_ID>(a.in[10] + (size_t)l * DFF * DM, DM, nullptr, (bf16_t*)(wl + W_2OUT), DFF, 0, DM / 32, scr, r, lane); continue; } r -= I2;
                    if (r < I5) { tr_item<MAP_WIN>(a.in[11] + (size_t)l * DM * DIN, DIN, nullptr, (bf16_t*)(wl + W_IN), DM, 0, DINP / 32, scr, r, lane); continue; } r -= I5;
                    if (r < I6) { tr_item<MAP_UPQ>(a.in[14] + (size_t)l * 256 * 768, 768, a.in[12] + l * 256, (bf16_t*)wu, KUP, 0, 768 / 32, scr, r, lane); continue; } r -= I6;
                    if (r < I8) { tr_item<MAP_UPK>(a.in[15] + (size_t)l * 128 * 1024, 1024, a.in[13] + l * 128, (bf16_t*)wu + 768 * KUP, KUP, 256, 512 / 32, scr, r, lane); continue; } r -= I8;
                    if (r < I8) { tr_item<MAP_VT>(a.in[15] + (size_t)l * 128 * 1024, 1024, a.in[13] + l * 128, (bf16_t*)(wu + WUP_VT), KUP, 256, 512 / 32, scr, r, lane); continue; } r -= I8;
                    tr_item<MAP_ID>(a.in[17] + (size_t)l * DM * DM, DM, nullptr, (bf16_t*)(wl + W_OUT), DM, 0, DM / 32, scr, r, lane);
                } else if (it < N_TR + N_ADA) {
                    int r = it - N_TR; const int l = r / 1152; r %= 1152; const int cgp = r >> 3, kc = r & 7, j = 64 * cgp + lane, k0 = 128 * kc;
#pragma unroll
                    for (int i2 = 0; i2 < 2; ++i2) { const int k = k0 + lane + 64 * i2; const float c0 = a.in[1][k], c1 = a.in[1][DM + k], c2 = a.in[3][k];
                        scr[lane + 64 * i2] = c0 / (1.0f + __expf(-c0)); scr[128 + lane + 64 * i2] = c1 / (1.0f + __expf(-c1)); scr[256 + lane + 64 * i2] = c2 / (1.0f + __expf(-c2)); }
                    asm volatile("s_waitcnt lgkmcnt(0)" ::: "memory");
                    float a0 = 0.f, a1 = 0.f, a2 = 0.f;
                    const float* wp = a.in[4] + ((size_t)l * DM + k0) * NMOD + j;
                    for (int kb = 0; kb < 128; kb += 32) {
                        float wv[32];
#pragma unroll
                        for (int kk = 0; kk < 32; ++kk) wv[kk] = wp[(size_t)(kb + kk) * NMOD];
#pragma unroll
                        for (int kk = 0; kk < 32; ++kk) { a0 += scr[kb + kk] * wv[kk]; a1 += scr[128 + kb + kk] * wv[kk]; a2 += scr[256 + kb + kk] * wv[kk]; }
                    }
                    if (kc == 0) { const float bb = a.in[5][l * NMOD + j]; a0 += bb; a1 += bb; a2 += bb; }
                    atomicAdd(mod + (size_t)(l * 3 + 0) * NMOD + j, a0); atomicAdd(mod + (size_t)(l * 3 + 1) * NMOD + j, a1); atomicAdd(mod + (size_t)(l * 3 + 2) * NMOD + j, a2);
                    asm volatile("s_waitcnt lgkmcnt(0)" ::: "memory");
                } else {
                    for (int e = lane; e < 1024; e += 64) {
                        const int pos = e >> 3, i = e & 7;
                        float th = (i & 1) ? 0.31622776601683794f : 1.0f;
                        for (int q = 0; q < (i >> 1); ++q) th *= 0.1f;
                        const float x2 = th * th;
                        const float c1 = 1.0f + x2 * (-0.5f + x2 * (4.1666666666666664e-2f + x2 * (-1.3888888888888889e-3f + x2 * (2.4801587301587302e-5f + x2 * (-2.7557319223985888e-7f + x2 * 2.08767569878681e-9f)))));
                        const float s1 = th * (1.0f + x2 * (-1.6666666666666666e-1f + x2 * (8.3333333333333332e-3f + x2 * (-1.9841269841269841e-4f + x2 * (2.7557319223985893e-6f + x2 * (-2.505210838544172e-8f + x2 * 1.6059043836821613e-10f))))));
                        float c = 1.0f, sn = 0.0f;
                        for (int bit = 6; bit >= 0; --bit) {
                            const float c2 = c * c - sn * sn, s2 = 2.0f * c * sn; c = c2; sn = s2;
                            if ((pos >> bit) & 1) { const float c3 = c * c1 - sn * s1, s3 = sn * c1 + c * s1; c = c3; sn = s3; }
                        }
                        rope[2 * e] = c; rope[2 * e + 1] = sn;
                    }
                }
            }
        } else if (ph == 1) {
            const int lane = fresh_lane(); const int tid = wave0 * 64 + lane; (void)tid; (void)lane;
            constexpr int N_SW = 2 * 832, N_X4 = MT / 4;
            for (int it = gw; it < N_SW + N_X4; it += NGW) {
                if (it < N_SW) {
                    const int l = it / 832; int r = it % 832;
                    const bf16_t* Bt; int chunk, N, n0; float* outp;
                    unsigned char* wl = ws + WS_W + (size_t)l * W_L;
                    if (r < 352) { Bt = (const bf16_t*)(wl + W_1IN); chunk = 0; N = NFF; n0 = 16 * r; outp = sWall + l * SW_L; }
                    else if (r < 704) { Bt = (const bf16_t*)(wl + W_2IN); chunk = 6; N = NFF; n0 = 16 * (r - 352); outp = sWall + l * SW_L + 3 * NFF; }
                    else { Bt = (const bf16_t*)(wl + W_IN); chunk = 3; N = DINP; n0 = 16 * (r - 704); outp = sWall + l * SW_L + 6 * NFF; }
                    f32x4 sh[3][4];
#pragma unroll
                    for (int s = 0; s < 3; ++s)
#pragma unroll
                        for (int q = 0; q < 4; ++q) sh[s][q] = *(const f32x4*)(mod + (size_t)(l * 3 + s) * NMOD + chunk * DM + 16 * lane + 4 * q);
#pragma unroll 1
                    for (int r4 = 0; r4 < 16; r4 += 4) {
                        u32x4 w0[4], w1[4];
#pragma unroll
                        for (int j = 0; j < 4; ++j) { w0[j] = *(const u32x4*)(Bt + (size_t)(n0 + r4 + j) * DM + 16 * lane); w1[j] = *(const u32x4*)(Bt + (size_t)(n0 + r4 + j) * DM + 16 * lane + 8); }
                        float d[4][3];
#pragma unroll
                        for (int j = 0; j < 4; ++j) {
                            const f32x4 f0 = (f32x4){bf_lo(w0[j].x), bf_hi(w0[j].x), bf_lo(w0[j].y), bf_hi(w0[j].y)}, f1 = (f32x4){bf_lo(w0[j].z), bf_hi(w0[j].z), bf_lo(w0[j].w), bf_hi(w0[j].w)};
                            const f32x4 f2 = (f32x4){bf_lo(w1[j].x), bf_hi(w1[j].x), bf_lo(w1[j].y), bf_hi(w1[j].y)}, f3 = (f32x4){bf_lo(w1[j].z), bf_hi(w1[j].z), bf_lo(w1[j].w), bf_hi(w1[j].w)};
#pragma unroll
                            for (int s = 0; s < 3; ++s) d[j][s] = sum4(f0 * sh[s][0] + f1 * sh[s][1] + f2 * sh[s][2] + f3 * sh[s][3]);
                        }
#pragma unroll
                        for (int o = 1; o < 64; o <<= 1)
#pragma unroll
                            for (int j = 0; j < 4; ++j)
#pragma unroll
                                for (int s = 0; s < 3; ++s) d[j][s] += shx(d[j][s], o, lane);
                        if (lane == 0) {
#pragma unroll
                            for (int j = 0; j < 4; ++j) { outp[n0 + r4 + j] = d[j][0]; outp[N + n0 + r4 + j] = d[j][1]; outp[2 * N + n0 + r4 + j] = d[j][2]; }
                        }
                    }
                } else {
                    const int m0 = 4 * (it - N_SW); const int s = m0 < SEQ ? 0 : (m0 < ML ? 1 : 2);
                    const float* src = m0 < ML ? x_in + (size_t)m0 * DM : ctx_in + (size_t)(m0 - ML) * DM;
                    f32x4 v[4][4], wm[4];
#pragma unroll
                    for (int rr = 0; rr < 4; ++rr)
#pragma unroll
                        for (int j = 0; j < 4; ++j) v[rr][j] = *(const f32x4*)(src + (size_t)rr * DM + 4 * lane + 256 * j);
#pragma unroll
                    for (int j = 0; j < 4; ++j) { const int col = 4 * lane + 256 * j; wm[j] = (*(const f32x4*)(norm_w + col)) * (*(const f32x4*)(mod + (size_t)s * NMOD + DM + col) + 1.0f); }
                    float q[4];
#pragma unroll
                    for (int rr = 0; rr < 4; ++rr) {
                        q[rr] = (dot4(v[rr][0]) + dot4(v[rr][1])) + (dot4(v[rr][2]) + dot4(v[rr][3]));
#pragma unroll
                        for (int j = 0; j < 4; ++j) { const f32x4 y = v[rr][j] * wm[j]; u32x2 w; w.x = cvt_pk_bf16(y.x, y.y); w.y = cvt_pk_bf16(y.z, y.w); *(u32x2*)(Xw + (size_t)(m0 + rr) * DM + 4 * lane + 256 * j) = w; }
                    }
#pragma unroll
                    for (int o = 1; o < 64; o <<= 1)
#pragma unroll
                        for (int rr = 0; rr < 4; ++rr) q[rr] += shx(q[rr], o, lane);
                    const float qsel = (lane >> 4) == 0 ? q[0] : ((lane >> 4) == 1 ? q[1] : ((lane >> 4) == 2 ? q[2] : q[3]));
                    ssqp[(size_t)m0 * 16 + lane] = (lane & 15) == 0 ? qsel : 0.f;
                }
            }
        } else if (ph == 18) {
            const int lane = fresh_lane(); const int tid = wave0 * 64 + lane; (void)tid; (void)lane;
            const float* fnw = a.in[18];
            for (int m = gw; m < ML; m += NGW) {
                const float t = wave_sum(lane < 16 ? ssqp[(size_t)m * 16 + lane] : 0.f, lane);
                const float rr = rsqrtf(t * (1.0f / 1024.0f) + EPS);
#pragma unroll
                for (int j = 0; j < 4; ++j) { const int col = 4 * lane + 256 * j; float* p = a.out + (size_t)m * DM + col; *(f32x4*)p = *(const f32x4*)p * rr * (*(const f32x4*)(fnw + col)); }
            }
        } else {
            const int l = (ph - 2) >> 3, k = (ph - 2) & 7;
            unsigned char* wl = ws + WS_W + (size_t)l * W_L;
            unsigned char* wu = ws + WS_WUP + (size_t)l * WUP_L;
            const float* modl = mod + (size_t)l * 3 * NMOD;
            float* sWl = sWall + l * SW_L;
            pg8::StaticOrder S;
            if (k == 0 || k == 6) {
                const int lane = fresh_lane(); const int tid = wave0 * 64 + lane; (void)tid; (void)lane;
                const int M = (l == 1 && k == 6) ? ML : MT;
                pg8::Gemm g{Xw, (const bf16_t*)(wl + (k == 0 ? W_1IN : W_2IN)), M, NFF, DM, DM, DM};
                const bool piped = (G == 256);
                unsigned* cntf = (unsigned*)(ws + WS_CNT) + (l * 2 + (k == 0 ? 0 : 1)) * 128;
                S.init(M, NFF, G, bx, 4, piped ? 1 : 0);
                pg8::EpiSwiglu E{Hb, ssqp, sWl + (k == 0 ? 0 : 3 * NFF), piped ? cntf : nullptr};
                pg8::gemm_phase<pg8::EpiSwiglu>(lds, g, S, E, tid);
            } else if (k == 1 || k == 7 || k == 5) {
                const int lane = fresh_lane(); const int tid = wave0 * 64 + lane; (void)tid; (void)lane;
                const int M = (l == 1 && k != 1) ? ML : MT;
                const bool kw = (k == 5), k1 = (k == 1);
                const bf16_t* gA = kw ? MIXb : Hb;
                const bf16_t* gB = (const bf16_t*)(wl + (kw ? W_OUT : (k1 ? W_1OUT : W_2OUT)));
                const int gK = kw ? DM : DFF;
                const float* xo_l = (k1 && l == 0) ? x_in : a.out;
                const float* xo_c = (k1 && l == 0) ? ctx_in : xctx;
                const float* gatep = modl + (kw ? 5 : (k1 ? 2 : 8)) * DM;
                const float* nwp = kw ? norm_w + (l * 3 + 2) * DM : (k1 ? norm_w + (l * 3 + 1) * DM : norm_w + 3 * DM);
                const float* nsp = kw ? modl + 7 * DM : (k1 ? modl + 4 * DM : mod + (size_t)3 * NMOD + DM);
                const bool has_ctx = (M == MT);
                const pg8::Gemm g{gA, gB, ML, DM, gK, gK, gK};
                const pg8::EpiResid E{xo_l, xo_c, a.out, xctx, gatep, nwp, nsp, Xw, ssqp, kw ? 1 : 0, (kw || k1 || l == 0) ? 1 : 0};
                const bool piped = (G == 256) && !kw;
                unsigned* cntf = (unsigned*)(ws + WS_CNT) + (l * 2 + (k1 ? 0 : 1)) * 128;
                if (piped) {
                    const int xq = bx & 7, tl = 31 - (bx >> 3), offp = (tl & 3) * 8 + (tl >> 2);
                    S.init(ML, DM, G, offp * 8 + xq);
                    pg8::Unit u0; S.next(0, u0);
                    if (tid == 0) {
                        unsigned spins = 0;
                        while (__hip_atomic_load(cntf + u0.pm, __ATOMIC_RELAXED, __HIP_MEMORY_SCOPE_AGENT) < 176u) { __builtin_amdgcn_s_sleep(8); if (++spins > (1u << 22)) break; }
                        __builtin_amdgcn_fence(__ATOMIC_ACQUIRE, "agent");
                        asm volatile("s_waitcnt vmcnt(0)" ::: "memory");
                    }
                    __syncthreads();
                } else S.init(ML, DM, G, bx);
                pg8::gemm_phase<pg8::EpiResid>(lds, g, S, E, tid);
                if (has_ctx) {
                    if (piped) {
                        const int offb = bx >> 3;
                        if (offb >= 24) {
                            if (wave0 == 0 && fresh_lane() == 0) {
                                unsigned spins = 0;
                                while (__hip_atomic_load(cntf + 64, __ATOMIC_RELAXED, __HIP_MEMORY_SCOPE_AGENT) < 176u || __hip_atomic_load(cntf + 65, __ATOMIC_RELAXED, __HIP_MEMORY_SCOPE_AGENT) < 176u) { __builtin_amdgcn_s_sleep(8); if (++spins > (1u << 22)) break; }
                                __builtin_amdgcn_fence(__ATOMIC_ACQUIRE, "agent");
                                asm volatile("s_waitcnt vmcnt(0)" ::: "memory");
                            }
                            __syncthreads();
                            pg8::skinny_ctx<pg8::EpiResid>(lds, g, E, DM / 256, (31 - offb) * 8 + (bx & 7), 64, wave0, fresh_lane());
                        }
                    } else pg8::skinny_ctx<pg8::EpiResid>(lds, g, E, DM / 256, bx, G, wave0, fresh_lane());
                }
            } else if (k == 2) {
                const int lane = fresh_lane(); const int tid = wave0 * 64 + lane; (void)tid; (void)lane;
                pg8::Gemm g{Xw, (const bf16_t*)(wl + W_IN), ML, DINP, DM, DM, DM};
                S.init(ML, DINP, G, bx);
                pg8::EpiInproj E{Pb, KPEb, ssqp, sWl + 6 * NFF, ssqq, ssqkv, rope};
                pg8::gemm_phase<pg8::EpiInproj>(lds, g, S, E, tid);
                pg8::skinny_ctx<pg8::EpiInproj>(lds, g, E, DINP / 256, bx, G, wave0, fresh_lane());
            } else if (k == 3) {
                const int tid = wave0 * 64 + fresh_lane();
                { pg8::Gemm g{Pb, (const bf16_t*)wu, MT, NUP, KUP, DINP, KUP};
                  S.init(MT, NUP, G, bx);
                  pg8::EpiUpQK E{Qb, KNb, ssqq, ssqkv, rope};
                  pg8::gemm_phase<pg8::EpiUpQK>(lds, g, S, E, tid); }
                { pg8::Gemm g{(const bf16_t*)(wu + WUP_VT), Pb, 512, MT, KUP, KUP, DINP};
                  S.init(512, MT, G, G - 1 - bx);
                  pg8::EpiVT E{VTb, ssqkv};
                  pg8::gemm_phase<pg8::EpiVT>(lds, g, S, E, wave0 * 64 + fresh_lane()); }
                const int lane = fresh_lane();
                const float* cw = a.in[16] + (size_t)l * 3 * 512 + 8 * lane;
                float w0[8], w1[8], w2[8];
#pragma unroll
                for (int c = 0; c < 8; ++c) { w0[c] = cw[c]; w1[c] = cw[512 + c]; w2[c] = cw[1024 + c]; }
                const int nit = (l == 1) ? ML / 8 : MT / 8;
                for (int it = gw; it < nit; it += NGW) {
                    const int m0 = 8 * it; const int Lm = (m0 < ML) ? (SEQ - 1) : 255;
                    const bool first = (m0 & Lm) == 0, last = ((m0 + 8) & Lm) == 0;
                    const bf16_t* pr = Pb + (size_t)m0 * DINP + 8 * lane;
                    u32x4 gcr[10], xvr[10], gbr[8];
#pragma unroll
                    for (int i = 0; i < 10; ++i) {
                        const bool valid = (i == 0) ? !first : ((i == 9) ? !last : true);
                        const bf16_t* rp = pr + (ptrdiff_t)(i - 1) * DINP;
                        gcr[i] = valid ? *(const u32x4*)(rp + 928) : (u32x4){0u, 0u, 0u, 0u};
                        xvr[i] = valid ? *(const u32x4*)(rp + 1440) : (u32x4){0u, 0u, 0u, 0u};
                    }
#pragma unroll
                    for (int i = 0; i < 8; ++i) gbr[i] = *(const u32x4*)(pr + (size_t)i * DINP + 416);
                    float up[8], uc[8], un[8];
#define MKU(dst, g_, x_) do { dst[0] = bf_lo(g_.x) * bf_lo(x_.x); dst[1] = bf_hi(g_.x) * bf_hi(x_.x); dst[2] = bf_lo(g_.y) * bf_lo(x_.y); dst[3] = bf_hi(g_.y) * bf_hi(x_.y); \
                        dst[4] = bf_lo(g_.z) * bf_lo(x_.z); dst[5] = bf_hi(g_.z) * bf_hi(x_.z); dst[6] = bf_lo(g_.w) * bf_lo(x_.w); dst[7] = bf_hi(g_.w) * bf_hi(x_.w); } while (0)
                    MKU(up, gcr[0], xvr[0]); MKU(uc, gcr[1], xvr[1]);
#pragma unroll
                    for (int i = 0; i < 8; ++i) {
                        MKU(un, gcr[i + 2], xvr[i + 2]);
                        const u32x4 gb = gbr[i];
                        float gbf[8] = {bf_lo(gb.x), bf_hi(gb.x), bf_lo(gb.y), bf_hi(gb.y), bf_lo(gb.z), bf_hi(gb.z), bf_lo(gb.w), bf_hi(gb.w)};
                        float y[8];
#pragma unroll
                        for (int c = 0; c < 8; ++c) { y[c] = gbf[c] * (w0[c] * up[c] + w1[c] * uc[c] + w2[c] * un[c]); up[c] = uc[c]; uc[c] = un[c]; }
                        u32x4 o; o.x = cvt_pk_bf16(y[0], y[1]); o.y = cvt_pk_bf16(y[2], y[3]); o.z = cvt_pk_bf16(y[4], y[5]); o.w = cvt_pk_bf16(y[6], y[7]);
                        *(u32x4*)(MIXb + (size_t)(m0 + i) * DM + 512 + 8 * lane) = o;
                    }
#undef MKU
                }
            } else {
                const int lane = fresh_lane(); const int tid = wave0 * 64 + lane; (void)tid; (void)lane;
                const int xcd = bx & 7, li = bx >> 3;
                if (G == 256) {
                    { const int bh = 2 * xcd + (li >> 4); attn_unit2(lds, Qb, KNb, KPEb, VTb, MIXb, bh >> 3, bh & 7, (bh >> 3) * SEQ + (li & 15) * 512, 132, tid); }
                } else {
                    for (int uidx = bx; uidx < 512; uidx += G) { const int bh = uidx >> 5; attn_unit(lds, Qb, KNb, KPEb, VTb, MIXb, bh >> 3, bh & 7, (bh >> 3) * SEQ + (uidx & 31) * 256, 132, tid); }
                }
                if (l == 0) for (int uidx = bx; uidx < 16; uidx += G) attn_unit(lds, Qb, KNb, KPEb, VTb, MIXb, uidx >> 3, uidx & 7, ML + (uidx >> 3) * 256, 4, tid);
            }
        }
        { const bool ffn_in_seam = (ph >= 2 && ph < 18 && (((ph - 2) & 7) == 0 || ((ph - 2) & 7) == 6)) && (int)gridDim.x == 256;
          if (it + 1 < it_hi && !ffn_in_seam) grid.sync(); }
    }
    }
}

extern "C" void kernel_launch(void* const* d_in, const int* in_sizes, int n_in, void* d_out, int out_size, void* d_ws, size_t ws_size, hipStream_t stream) {
    static int grid_blocks = 0;
    if (grid_blocks == 0) {
        if (n_in != 19 || out_size != ML * DM || ws_size < WS_END) { fprintf(stderr, "kernel_launch: unexpected shapes (n_in %d out %d ws %zu need %zu)\n", n_in, out_size, ws_size, (size_t)WS_END); grid_blocks = -1; return; }
        int dev = 0, cus = 0, per_cu = 0;
        hipGetDevice(&dev);
        hipDeviceGetAttribute(&cus, hipDeviceAttributeMultiprocessorCount, dev);
        hipFuncSetAttribute((const void*)mega_fwd, hipFuncAttributeMaxDynamicSharedMemorySize, LDS_BYTES);
        hipOccupancyMaxActiveBlocksPerMultiprocessor(&per_cu, (const void*)mega_fwd, 512, LDS_BYTES);
        if (per_cu < 1) { fprintf(stderr, "kernel_launch: occupancy query says %d blocks/CU\n", per_cu); per_cu = 1; }
        if (per_cu > 1) per_cu = 1;
        grid_blocks = cus * per_cu;
    }
    if (grid_blocks < 0) return;
    hipMemsetAsync(d_ws, 0, ZERO_BYTES, stream);
    Args a{};
    for (int i = 0; i < 19; ++i) a.in[i] = (const float*)d_in[i];
    a.out = (float*)d_out; a.ws = (unsigned char*)d_ws;
#if MK_PER_PHASE_LAUNCH
    for (int ph = 0; ph < 19; ++ph) {
        a.ph_lo = ph; a.ph_hi = ph + 1;
        void* args[] = {&a};
        hipError_t e = hipLaunchCooperativeKernel((const void*)mega_fwd, dim3(grid_blocks), dim3(512), args, LDS_BYTES, stream);
        if (e != hipSuccess) { fprintf(stderr, "launch failed: %s\n", hipGetErrorString(e)); break; }
    }
#else
    a.ph_lo = 0; a.ph_hi = 19;
    void* args[] = {&a};
    hipError_t e = hipLaunchCooperativeKernel((const void*)mega_fwd, dim3(grid_blocks), dim3(512), args, LDS_BYTES, stream);
    if (e != hipSuccess) fprintf(stderr, "cooperative launch failed: %s (grid %d)\n", hipGetErrorString(e), grid_blocks);
#endif
}
```

```cpp
#include <hip/hip_runtime.h>
#include <hip/hip_cooperative_groups.h>
#include <cstdio>
#include <cstdint>
namespace cg = cooperative_groups;

#ifndef PROBE_DUP
#define PROBE_DUP (-1)
#endif
#ifndef MK_PER_PHASE_LAUNCH
#define MK_PER_PHASE_LAUNCH 0
#endif

#define LAS __attribute__((address_space(3)))
typedef unsigned short bf16_t;
typedef short bf16x8 __attribute__((ext_vector_type(8)));
typedef float f32x4 __attribute__((ext_vector_type(4)));
typedef float f32x2 __attribute__((ext_vector_type(2)));
typedef float f32x16 __attribute__((ext_vector_type(16)));
typedef unsigned u32x4 __attribute__((ext_vector_type(4)));
typedef unsigned u32x2 __attribute__((ext_vector_type(2)));

constexpr int DM = 1024, SEQ = 8192, ML = 16384, MC = 512, MT = 16896, DFF = 2816, NFF = 5632, DIN = 1952, DINP = 2048;
constexpr int NUP = 1280, KUP = 384, NMOD = 9216;
constexpr float EPS = 1e-6f;
constexpr float C2 = 0.10206207261596577f * 1.4426950408889634f;

constexpr size_t WS_MOD = 0;
constexpr size_t WS_CNT = 229376;
constexpr size_t WS_WUP = 262144;
constexpr size_t WUP_L = 1376256, WUP_VT = 983040;
constexpr size_t ZERO_BYTES = 262144 + 2 * WUP_L;
constexpr size_t WS_ROPE = ZERO_BYTES;
constexpr size_t WS_SW = WS_ROPE + 8192;
constexpr size_t SW_L = 39936;
constexpr size_t WS_SSQP = WS_SW + 2 * SW_L * 4;
constexpr size_t WS_SSQQ = WS_SSQP + (size_t)MT * 64;
constexpr size_t WS_SSQKV = WS_SSQQ + (size_t)MT * 16;
constexpr size_t WS_W = 5242880;
constexpr size_t W_1IN = 0, W_1OUT = 11534336, W_2IN = 17301504, W_2OUT = 28835840, W_IN = 34603008, W_OUT = 38797312, W_L = 40894464;
constexpr size_t WS_XCTX = WS_W + 2 * W_L;
constexpr size_t WS_XW = WS_XCTX + (size_t)MC * DM * 4;
constexpr size_t WS_H = WS_XW + (size_t)MT * DM * 2;
constexpr size_t WS_P = WS_H, WS_KN = WS_P + (size_t)MT * DINP * 2, WS_KPE = WS_KN + (size_t)MT * 512 * 2;
constexpr size_t WS_VT = WS_H + (size_t)MT * DFF * 2;
constexpr size_t WS_MIX = WS_VT + (size_t)512 * MT * 2;
constexpr size_t WS_END = WS_MIX + (size_t)MT * DM * 2;
static_assert(WS_SSQKV + (size_t)MT * 16 <= WS_W, "small region");
static_assert(WS_KPE + (size_t)MT * 64 <= WS_VT, "overlay");

constexpr int LDS_BYTES = 131072;

typedef __bf16 bf16x2_t __attribute__((ext_vector_type(2)));
__device__ __forceinline__ unsigned cvt_pk_bf16(float lo, float hi) { const f32x2 v = {lo, hi}; return __builtin_bit_cast(unsigned, __builtin_convertvector(v, bf16x2_t)); }
__device__ __forceinline__ float bf_lo(unsigned w) { return __builtin_bit_cast(float, w << 16); }
__device__ __forceinline__ float bf_hi(unsigned w) { return __builtin_bit_cast(float, w & 0xffff0000u); }
__device__ __forceinline__ float shx(float v, int o, int lane) { return __builtin_bit_cast(float, __builtin_amdgcn_ds_bpermute((lane ^ o) << 2, __builtin_bit_cast(int, v))); }
__device__ __forceinline__ float wave_sum(float v, int lane) {
#pragma unroll
    for (int o = 1; o < 64; o <<= 1) v += shx(v, o, lane);
    return v;
}
__device__ __forceinline__ float fast_silu(float g) { return g * __builtin_amdgcn_rcpf(1.0f + __builtin_amdgcn_exp2f(-1.4426950408889634f * g)); }
__device__ __forceinline__ float sum4(f32x4 v) { return (v.x + v.y) + (v.z + v.w); }
__device__ __forceinline__ float dot4(f32x4 v) { return (v.x * v.x + v.y * v.y) + (v.z * v.z + v.w * v.w); }
__device__ __forceinline__ float quad_sum(float t, int lane) { t += shx(t, 16, lane); t += shx(t, 32, lane); return t; }

__device__ __forceinline__ int fresh_lane() { int l; asm volatile("v_mbcnt_lo_u32_b32 %0, -1, 0\n\tv_mbcnt_hi_u32_b32 %0, -1, %0" : "=v"(l)); return l; }

namespace pg8 {
constexpr int BM = 256, BK = 64, HALF = 128, HTB = HALF * BK * 2, STAGE_BYTES = 8 * HTB, NXCD = 8, WGM = 8;
__host__ __device__ __forceinline__ int lds_byte(int r, int c) { const int st = (r >> 4) * 2 + (c >> 5), rr = r & 15, cc = c & 31, ob = rr * 64 + cc * 2; return st * 1024 + (ob ^ (((ob >> 9) & 1) << 5)); }
__host__ __device__ __forceinline__ void stage_rc(int b, int& R, int& C) { const int st = b / 1024, sb = b % 1024, swz = sb ^ (((sb >> 9) & 1) << 5); R = (st >> 1) * 16 + swz / 64; C = (st & 1) * 32 + (swz % 64) / 2; }
__host__ __device__ __forceinline__ int perm32(int rho) { const int n = rho >> 4, i = rho & 15; return 8 * (i >> 2) + 4 * n + (i & 3); }

struct Unit { int pm, pn; };
struct Gemm { const bf16_t* A; const bf16_t* Bt; int M, N, K, lda, ldb; };

struct StaticOrder {
    int nM, nN, nwg, G, c, wgm, xrow;
    __device__ __forceinline__ void init(int M, int N, int G_, int c_, int wgm_ = WGM, int xrow_ = 0) { nM = M / BM; nN = N / BM; nwg = nM * nN; G = G_; c = c_; wgm = wgm_; xrow = xrow_; }
    __device__ __forceinline__ bool next(int i, Unit& u) const {
        if (xrow) {
            const int x = c & 7, j = i * 32 + (c >> 3), nlat = 8 * nN;
            if (j < nlat) { const int grp = j / (4 * nN), w = j % (4 * nN); u.pm = 8 * x + 4 * grp + (w & 3); u.pn = w >> 2; return true; }
            const int ci = (j - nlat) * 8 + x;
            if (nM <= 64 || ci >= 2 * nN) return false;
            u.pm = 64 + ci / nN; u.pn = ci % nN; return true;
        }
        const long L = (long)i * G + c; if (L >= nwg) return false;
        int wgid = (int)L; { const int q = nwg / NXCD, r = nwg % NXCD, xcd = wgid % NXCD, off = wgid / NXCD; wgid = (xcd < r ? xcd * (q + 1) : r * (q + 1) + (xcd - r) * q) + off; }
        const int nig = wgm * nN, gid = wgid / nig, fm = gid * wgm, gsz = (nM - fm) < wgm ? (nM - fm) : wgm;
        u.pm = fm + ((wgid % nig) % gsz); u.pn = (wgid % nig) / gsz; return true;
    }
};

template <class Epi>
__device__ __forceinline__ void gemm_phase(LAS unsigned char* lds, const Gemm g, const StaticOrder& S, const Epi& E, const int tid_in) {
    int tid = tid_in; asm volatile("" : "+v"(tid));
    const int wid = __builtin_amdgcn_readfirstlane(tid >> 6), lane = tid & 63, wr = wid >> 2, wc = wid & 3, fr = lane & 15, fq = lane >> 4;
    const int K = g.K, nt = K / BK;
    unsigned voffA[2], voffB[2];
#pragma unroll
    for (int i = 0; i < 2; ++i) { int R, C; stage_rc(tid * 16 + i * 8192, R, C); const int Rb = Epi::PERM ? ((R & ~31) + perm32(R & 31)) : R;
        voffA[i] = (unsigned)(R * g.lda + C) * 2u; voffB[i] = (unsigned)(Rb * g.ldb + C) * 2u; }
    const size_t kstep = (size_t)(BK * 2);
    const size_t hstepA = (size_t)HALF * g.lda * 2, hstepB = (size_t)HALF * g.ldb * 2;
    const size_t tstepA = 2 * hstepA, tstepB = 2 * hstepB;
    const unsigned ldsw = (unsigned)wid * 1024u;
    const int aoff = lds_byte(wr * 64 + fr, fq * 8), boff = lds_byte(wc * 32 + fr, fq * 8);
#define PG8_SA(b, h) (((b) * 2 + (h)) * HTB)
#define PG8_SB(b, h) ((4 + (b) * 2 + (h)) * HTB)
#define PG8_STAGE(bufoff, gbase, voff) do { _Pragma("unroll") for (int _i = 0; _i < 2; ++_i) \
        __builtin_amdgcn_global_load_lds((const unsigned*)((const char*)(gbase) + (voff)[_i]), (LAS unsigned*)(lds + (bufoff) + ldsw + _i * 8192), 16, 0, 0); } while (0)
#define PG8_LDA(dst, b, h) do { _Pragma("unroll") for (int m = 0; m < 4; ++m) _Pragma("unroll") for (int k = 0; k < 2; ++k) dst[m][k] = *(const LAS bf16x8*)(lds + PG8_SA(b, h) + aoff + m * 2048 + k * 1024); } while (0)
#define PG8_LDB(dst, b, h) do { _Pragma("unroll") for (int n = 0; n < 2; ++n) _Pragma("unroll") for (int k = 0; k < 2; ++k) dst[n][k] = *(const LAS bf16x8*)(lds + PG8_SB(b, h) + boff + n * 2048 + k * 1024); } while (0)
#define PG8_MMA(ai, bj, At, Bt) do { __builtin_amdgcn_s_setprio(1); _Pragma("unroll") for (int m = 0; m < 4; ++m) _Pragma("unroll") for (int n = 0; n < 2; ++n) _Pragma("unroll") for (int k = 0; k < 2; ++k) \
        acc[ai][bj][m][n] = __builtin_amdgcn_mfma_f32_16x16x32_bf16(Bt[n][k], At[m][k], acc[ai][bj][m][n], 0, 0, 0); __builtin_amdgcn_s_setprio(0); } while (0)
#define PG8_WAIT_V(n) asm volatile("s_waitcnt vmcnt(" #n ")" ::: "memory")
#define PG8_WAIT_L(n) asm volatile("s_waitcnt lgkmcnt(" #n ")" ::: "memory")
#define PG8_BAR __builtin_amdgcn_s_barrier()
#define PG8_SCHED __builtin_amdgcn_sched_barrier(0)
    Unit cur, nxt; int ui = 0;
    if (!S.next(0, cur)) return;
    f32x4 acc[2][2][4][2];
#pragma unroll
    for (int a = 0; a < 2; ++a)
#pragma unroll
        for (int b = 0; b < 2; ++b)
#pragma unroll
            for (int m = 0; m < 4; ++m)
#pragma unroll
                for (int n = 0; n < 2; ++n) acc[a][b][m][n] = (f32x4){0.f, 0.f, 0.f, 0.f};
    bf16x8 At[4][2], B0[2][2], B1[2][2];
    const char* cA = (const char*)g.A + (size_t)cur.pm * tstepA; const char* cB = (const char*)g.Bt + (size_t)cur.pn * tstepB;
    PG8_STAGE(PG8_SB(0, 0), cB, voffB); PG8_STAGE(PG8_SB(0, 1), cB + hstepB, voffB); PG8_STAGE(PG8_SA(0, 0), cA, voffA); PG8_STAGE(PG8_SA(0, 1), cA + hstepA, voffA);
    if (wr == 1) PG8_BAR;
    PG8_WAIT_V(2); PG8_BAR;
    PG8_STAGE(PG8_SB(1, 0), cB + kstep, voffB); PG8_STAGE(PG8_SA(1, 0), cA + kstep, voffA); PG8_STAGE(PG8_SB(1, 1), cB + hstepB + kstep, voffB);
    PG8_WAIT_V(6); PG8_BAR;
    for (;;) {
        const bool has_next = S.next(ui + 1, nxt);
        const char* nA = has_next ? (const char*)g.A + (size_t)nxt.pm * tstepA : cA; const char* nB = has_next ? (const char*)g.Bt + (size_t)nxt.pn * tstepB : cB;
        for (int t = 0; t < nt; t += 2) {
            const bool last = (t == nt - 2);
            const char* a1 = cA + (size_t)(t + 1) * kstep;
            const char* a2 = last ? nA : cA + (size_t)(t + 2) * kstep; const char* b2 = last ? nB : cB + (size_t)(t + 2) * kstep;
            const char* a3 = a2 + kstep; const char* b3 = b2 + kstep;
            PG8_LDB(B0, 0, 0); PG8_LDB(B1, 0, 1); PG8_SCHED; PG8_LDA(At, 0, 0); PG8_STAGE(PG8_SA(1, 1), a1 + hstepA, voffA);
            PG8_WAIT_V(8); PG8_WAIT_L(0); PG8_BAR; PG8_MMA(0, 0, At, B0); PG8_MMA(0, 1, At, B1); PG8_BAR; PG8_SCHED;
            PG8_LDA(At, 0, 1); PG8_STAGE(PG8_SB(0, 0), b2, voffB); PG8_STAGE(PG8_SB(0, 1), b2 + hstepB, voffB); PG8_STAGE(PG8_SA(0, 0), a2, voffA);
            PG8_WAIT_V(8); PG8_WAIT_L(0); PG8_BAR; PG8_MMA(1, 0, At, B0); PG8_MMA(1, 1, At, B1); PG8_BAR; PG8_SCHED;
            PG8_LDB(B0, 1, 0); PG8_LDB(B1, 1, 1); PG8_SCHED; PG8_LDA(At, 1, 0); PG8_STAGE(PG8_SA(0, 1), a2 + hstepA, voffA);
            PG8_WAIT_V(8); PG8_WAIT_L(0); PG8_BAR; PG8_MMA(0, 0, At, B0); PG8_MMA(0, 1, At, B1); PG8_BAR; PG8_SCHED;
            PG8_LDA(At, 1, 1); PG8_STAGE(PG8_SB(1, 0), b3, voffB); PG8_STAGE(PG8_SB(1, 1), b3 + hstepB, voffB); PG8_STAGE(PG8_SA(1, 0), a3, voffA);
            PG8_WAIT_V(8); PG8_WAIT_L(0); PG8_BAR; PG8_MMA(1, 0, At, B0); PG8_MMA(1, 1, At, B1); PG8_BAR; PG8_SCHED;
        }
        if (wr == 0) PG8_BAR;
        E(acc, cur, wr, wc, fr, fq);
        if (!has_next) break;
#pragma unroll
        for (int a = 0; a < 2; ++a)
#pragma unroll
            for (int b = 0; b < 2; ++b)
#pragma unroll
                for (int m = 0; m < 4; ++m)
#pragma unroll
                    for (int n = 0; n < 2; ++n) acc[a][b][m][n] = (f32x4){0.f, 0.f, 0.f, 0.f};
        cur = nxt; cA = nA; cB = nB; ++ui;
        if (wr == 1) PG8_BAR;
    }
    PG8_WAIT_V(0);
    PG8_BAR;
#undef PG8_SA
#undef PG8_SB
#undef PG8_STAGE
#undef PG8_LDA
#undef PG8_LDB
#undef PG8_MMA
#undef PG8_WAIT_V
#undef PG8_WAIT_L
#undef PG8_BAR
#undef PG8_SCHED
}

__device__ __forceinline__ int stream_of(int pm) { return pm < 32 ? 0 : (pm < 64 ? 1 : 2); }

__device__ __forceinline__ void rope_apply(f32x4& a, f32x4& b, const float* rope, int row, int fq) {
    const int pos = (fq >> 1) ? (row & 63) : ((row >> 6) & 127);
    const float* tp = rope + (pos * 8 + 4 * (fq & 1)) * 2;
    const f32x4 cs0 = *(const f32x4*)tp, cs1 = *(const f32x4*)(tp + 4);
    const f32x4 c = (f32x4){cs0.x, cs0.z, cs1.x, cs1.z}, s = (f32x4){cs0.y, cs0.w, cs1.y, cs1.w};
    const f32x4 o1 = a * c - b * s, o2 = b * c + a * s; a = o1; b = o2;
}

struct EpiSwiglu {
    static constexpr bool PERM = true;
    bf16_t* H; const float* ssqp; const float* sW; unsigned* cnt;
    __device__ __forceinline__ void operator()(const f32x4 (&acc)[2][2][4][2], const Unit& u, int wr, int wc, int fr, int fq) const { run<0, 2>(acc, u, wr, wc, fr, fq); }
    template <int A0, int A1> __device__ __forceinline__ void run(const f32x4 (&acc)[2][2][4][2], const Unit& u, int wr, int wc, int fr, int fq) const {
        const int s = stream_of(u.pm);
        const int cb = u.pn * 256 + wc * 32 + fq * 8;
        const float* bp = sW + s * NFF + cb;
        f32x4 bg[2], bu[2];
#pragma unroll
        for (int n = 0; n < 2; ++n) { bg[n] = *(const f32x4*)(bp + 4 * n); bu[n] = *(const f32x4*)(bp + 128 + 4 * n); }
        const int row0 = u.pm * 256 + wr * 64 + fr;
#pragma unroll
        for (int ai = A0; ai < A1; ++ai)
#pragma unroll
            for (int m = 0; m < 4; ++m) {
                const int row = row0 + ai * 128 + m * 16;
                const float t = quad_sum(sum4(*(const f32x4*)(ssqp + (size_t)row * 16 + 4 * fq)), fq * 16 + fr);
                const float rr = rsqrtf(t * (1.0f / 1024.0f) + EPS);
                u32x4 w;
#pragma unroll
                for (int n = 0; n < 2; ++n) {
                    const f32x4 gg = acc[ai][0][m][n] * rr + bg[n], uu = acc[ai][1][m][n] * rr + bu[n];
                    const float h0 = fast_silu(gg.x) * uu.x, h1 = fast_silu(gg.y) * uu.y, h2 = fast_silu(gg.z) * uu.z, h3 = fast_silu(gg.w) * uu.w;
                    w[2 * n] = cvt_pk_bf16(h0, h1); w[2 * n + 1] = cvt_pk_bf16(h2, h3);
                }
                bf16_t* hp = H + (size_t)row * DFF + u.pn * 128 + wc * 32 + fq * 8;
                if (cnt) asm volatile("global_store_dwordx4 %0, %1, off sc0 sc1" :: "v"(hp), "v"(w) : "memory");
                else *(u32x4*)hp = w;
            }
        if (cnt && A1 - A0 == 2) {
            asm volatile("s_waitcnt vmcnt(0)" ::: "memory");
            if (fr == 0 && fq == 0) __hip_atomic_fetch_add(cnt + u.pm, 1u, __ATOMIC_RELAXED, __HIP_MEMORY_SCOPE_AGENT);
        }
    }
};

struct EpiResid {
    static constexpr bool PERM = true;
    const float* xo_lat; const float* xo_ctx; float* xn_lat; float* xn_ctx;
    const float* gate; const float* nw; const float* nscale; bf16_t* Xw; float* ssqp; int full_gate; int has_next;
    __device__ __forceinline__ void operator()(const f32x4 (&acc)[2][2][4][2], const Unit& u, int wr, int wc, int fr, int fq) const { run<0, 2>(acc, u, wr, wc, fr, fq); }
    template <int A0, int A1> __device__ __forceinline__ void run(const f32x4 (&acc)[2][2][4][2], const Unit& u, int wr, int wc, int fr, int fq) const {
        const int s = stream_of(u.pm);
        const float gmul = full_gate ? 1.0f : 0.5f;
        const float* xo = (u.pm < 64) ? xo_lat : xo_ctx - (size_t)ML * DM;
        float* xn = (u.pm < 64) ? xn_lat : xn_ctx - (size_t)ML * DM;
        const int row0 = u.pm * 256 + wr * 64 + fr;
        float ssq[2][4];
#pragma unroll
        for (int ai = A0; ai < A1; ++ai)
#pragma unroll
            for (int m = 0; m < 4; ++m) ssq[ai][m] = 0.f;
#pragma unroll
        for (int bj = 0; bj < 2; ++bj) {
            const int col = u.pn * 256 + bj * 128 + wc * 32 + fq * 8;
            const f32x4 gv0 = *(const f32x4*)(gate + s * NMOD + col) * gmul, gv1 = *(const f32x4*)(gate + s * NMOD + col + 4) * gmul;
            f32x4 wv0 = (f32x4){0.f, 0.f, 0.f, 0.f}, wv1 = wv0;
            if (has_next) { wv0 = *(const f32x4*)(nw + col) * (*(const f32x4*)(nscale + s * NMOD + col) + 1.0f); wv1 = *(const f32x4*)(nw + col + 4) * (*(const f32x4*)(nscale + s * NMOD + col + 4) + 1.0f); }
#pragma unroll
            for (int ai = A0; ai < A1; ++ai)
#pragma unroll
                for (int m = 0; m < 4; ++m) {
                    const size_t off = (size_t)(row0 + ai * 128 + m * 16) * DM + col;
                    const f32x4 x0 = *(const f32x4*)(xo + off) + gv0 * acc[ai][bj][m][0];
                    const f32x4 x1 = *(const f32x4*)(xo + off + 4) + gv1 * acc[ai][bj][m][1];
                    *(f32x4*)(xn + off) = x0; *(f32x4*)(xn + off + 4) = x1;
                    ssq[ai][m] += dot4(x0) + dot4(x1);
                    if (has_next) { const f32x4 y0 = x0 * wv0, y1 = x1 * wv1; u32x4 w; w.x = cvt_pk_bf16(y0.x, y0.y); w.y = cvt_pk_bf16(y0.z, y0.w); w.z = cvt_pk_bf16(y1.x, y1.y); w.w = cvt_pk_bf16(y1.z, y1.w); *(u32x4*)(Xw + off) = w; }
                }
        }
#pragma unroll
        for (int ai = A0; ai < A1; ++ai)
#pragma unroll
            for (int m = 0; m < 4; ++m) {
                const float t = quad_sum(ssq[ai][m], fq * 16 + fr);
                if (fq == 0) ssqp[(size_t)(row0 + ai * 128 + m * 16) * 16 + u.pn * 4 + wc] = t;
            }
    }
};

struct EpiInproj {
    static constexpr bool PERM = true;
    bf16_t* P; bf16_t* KPE; const float* ssqp; const float* sW; float* ssqq; float* ssqkv; const float* rope;
    __device__ __forceinline__ void operator()(const f32x4 (&acc)[2][2][4][2], const Unit& u, int wr, int wc, int fr, int fq) const { run<0, 2>(acc, u, wr, wc, fr, fq); }
    template <int A0, int A1> __device__ __forceinline__ void run(const f32x4 (&acc)[2][2][4][2], const Unit& u, int wr, int wc, int fr, int fq) const {
        const int s = stream_of(u.pm);
        const int cb = u.pn * 256 + wc * 32 + fq * 8;
        f32x4 b[2][2];
#pragma unroll
        for (int bj = 0; bj < 2; ++bj)
#pragma unroll
            for (int n = 0; n < 2; ++n) b[bj][n] = *(const f32x4*)(sW + s * DINP + cb + bj * 128 + 4 * n);
        const int row0 = u.pm * 256 + wr * 64 + fr;
#pragma unroll
        for (int ai = A0; ai < A1; ++ai)
#pragma unroll
            for (int m = 0; m < 4; ++m) {
                const int row = row0 + ai * 128 + m * 16;
                const float t = quad_sum(sum4(*(const f32x4*)(ssqp + (size_t)row * 16 + 4 * fq)), fq * 16 + fr);
                const float rr = rsqrtf(t * (1.0f / 1024.0f) + EPS);
                f32x4 v[2][2];
#pragma unroll
                for (int bj = 0; bj < 2; ++bj)
#pragma unroll
                    for (int n = 0; n < 2; ++n) v[bj][n] = acc[ai][bj][m][n] * rr + b[bj][n];
                if (u.pn == 0) {
                    const float q = quad_sum((dot4(v[0][0]) + dot4(v[0][1])) + (dot4(v[1][0]) + dot4(v[1][1])), fq * 16 + fr);
                    if (fq == 0) ssqq[(size_t)row * 4 + wc] = q;
                } else if (u.pn == 1) {
                    const float q = quad_sum(dot4(v[0][0]) + dot4(v[0][1]), fq * 16 + fr);
                    if (fq == 0) ssqkv[(size_t)row * 4 + wc] = q;
                }
#pragma unroll
                for (int bj = 0; bj < 2; ++bj) {
                    u32x4 w; w.x = cvt_pk_bf16(v[bj][0].x, v[bj][0].y); w.y = cvt_pk_bf16(v[bj][0].z, v[bj][0].w); w.z = cvt_pk_bf16(v[bj][1].x, v[bj][1].y); w.w = cvt_pk_bf16(v[bj][1].z, v[bj][1].w);
                    *(u32x4*)(P + (size_t)row * DINP + cb + bj * 128) = w;
                }
                if (u.pn == 1 && wc == 0) {
                    f32x4 a = v[1][0], bb = v[1][1];
                    if (u.pm < 64) rope_apply(a, bb, rope, row, fq);
                    u32x4 w; w.x = cvt_pk_bf16(a.x, a.y); w.y = cvt_pk_bf16(a.z, a.w); w.z = cvt_pk_bf16(bb.x, bb.y); w.w = cvt_pk_bf16(bb.z, bb.w);
                    *(u32x4*)(KPE + (size_t)row * 32 + fq * 8) = w;
                }
            }
    }
};

struct EpiUpQK {
    static constexpr bool PERM = true;
    bf16_t* Q; bf16_t* KN; const float* ssqq; const float* ssqkv; const float* rope; int pn_off;
    __device__ __forceinline__ void operator()(const f32x4 (&acc)[2][2][4][2], const Unit& u, int wr, int wc, int fr, int fq) const { run<0, 2>(acc, u, wr, wc, fr, fq); }
    template <int A0, int A1> __device__ __forceinline__ void run(const f32x4 (&acc)[2][2][4][2], const Unit& u, int wr, int wc, int fr, int fq) const {
        const int lpn = u.pn + pn_off;
        const bool isq = lpn < 3;
        const int row0 = u.pm * 256 + wr * 64 + fr;
#pragma unroll
        for (int ai = A0; ai < A1; ++ai)
#pragma unroll
            for (int m = 0; m < 4; ++m) {
                const int row = row0 + ai * 128 + m * 16;
                const f32x4 pv = isq ? *(const f32x4*)(ssqq + (size_t)row * 4) : *(const f32x4*)(ssqkv + (size_t)row * 4);
                const float rr = isq ? rsqrtf(sum4(pv) * (1.0f / 256.0f) + EPS) * C2 : rsqrtf(sum4(pv) * (1.0f / 128.0f) + EPS);
#pragma unroll
                for (int bj = 0; bj < 2; ++bj) {
                    const int cbase = lpn * 256 + bj * 128 + wc * 32;
                    f32x4 v0 = acc[ai][bj][m][0] * rr, v1 = acc[ai][bj][m][1] * rr;
                    if (isq && ((cbase >> 5) % 3) == 2 && u.pm < 64) rope_apply(v0, v1, rope, row, fq);
                    u32x4 w; w.x = cvt_pk_bf16(v0.x, v0.y); w.y = cvt_pk_bf16(v0.z, v0.w); w.z = cvt_pk_bf16(v1.x, v1.y); w.w = cvt_pk_bf16(v1.z, v1.w);
                    if (isq) *(u32x4*)(Q + (size_t)row * 768 + cbase + fq * 8) = w;
                    else *(u32x4*)(KN + (size_t)row * 512 + (cbase - 768) + fq * 8) = w;
                }
            }
    }
};

struct EpiVT {
    static constexpr bool PERM = true;
    bf16_t* VT; const float* ssqkv;
    __device__ __forceinline__ void operator()(const f32x4 (&acc)[2][2][4][2], const Unit& u, int wr, int wc, int fr, int fq) const { run<0, 2>(acc, u, wr, wc, fr, fq); }
    template <int A0, int A1> __device__ __forceinline__ void run(const f32x4 (&acc)[2][2][4][2], const Unit& u, int wr, int wc, int fr, int fq) const {
        f32x4 rr[2][2];
#pragma unroll
        for (int bj = 0; bj < 2; ++bj)
#pragma unroll
            for (int n = 0; n < 2; ++n) {
                const int tok0 = u.pn * 256 + bj * 128 + wc * 32 + fq * 8 + n * 4;
#pragma unroll
                for (int j = 0; j < 4; ++j) rr[bj][n][j] = rsqrtf(sum4(*(const f32x4*)(ssqkv + (size_t)(tok0 + j) * 4)) * (1.0f / 128.0f) + EPS);
            }
        const int drow0 = u.pm * 256 + wr * 64 + fr;
#pragma unroll
        for (int ai = A0; ai < A1; ++ai)
#pragma unroll
            for (int m = 0; m < 4; ++m) {
                const int drow = drow0 + ai * 128 + m * 16;
#pragma unroll
                for (int bj = 0; bj < 2; ++bj) {
                    const f32x4 v0 = acc[ai][bj][m][0] * rr[bj][0], v1 = acc[ai][bj][m][1] * rr[bj][1];
                    u32x4 w; w.x = cvt_pk_bf16(v0.x, v0.y); w.y = cvt_pk_bf16(v0.z, v0.w); w.z = cvt_pk_bf16(v1.x, v1.y); w.w = cvt_pk_bf16(v1.z, v1.w);
                    *(u32x4*)(VT + (size_t)drow * MT + u.pn * 256 + bj * 128 + wc * 32 + fq * 8) = w;
                }
            }
    }
};

template <class Epi, int AI>
__device__ __forceinline__ void skinny_item(LAS unsigned char* lds, const Gemm g, const Epi& E, const Unit u, int wr, int wc, int wave, int lane) {
    const int fr = lane & 15, fq = lane >> 4;
    f32x4 acc[2][2][4][2];
#pragma unroll
    for (int b = 0; b < 2; ++b)
#pragma unroll
        for (int m = 0; m < 4; ++m)
#pragma unroll
            for (int n = 0; n < 2; ++n) acc[AI][b][m][n] = (f32x4){0.f, 0.f, 0.f, 0.f};
    const bf16_t* pa = g.A + (size_t)(u.pm * 256 + AI * 128 + wr * 64 + fr) * g.lda + fq * 8;
    const bf16_t* pb0 = g.Bt + (size_t)(u.pn * 256 + wc * 32 + (Epi::PERM ? perm32(fr) : fr)) * g.ldb + fq * 8;
    const bf16_t* pb1 = g.Bt + (size_t)(u.pn * 256 + wc * 32 + (Epi::PERM ? perm32(16 + fr) : 16 + fr)) * g.ldb + fq * 8;
    const size_t as = (size_t)16 * g.lda, bs = (size_t)128 * g.ldb;
    const int nch = g.K >> 7, kbeg = ((wave * nch) >> 3) << 7, kend = (((wave + 1) * nch) >> 3) << 7;
    bf16x8 a0[2][4], b0[2][2][2], a1[2][4], b1[2][2][2];
#define SK_LOAD(A_, B_, kb) do { _Pragma("unroll") for (int kk = 0; kk < 2; ++kk) { \
        _Pragma("unroll") for (int m = 0; m < 4; ++m) A_[kk][m] = *(const bf16x8*)(pa + m * as + (kb) + 32 * kk); \
        _Pragma("unroll") for (int bj = 0; bj < 2; ++bj) { B_[kk][bj][0] = *(const bf16x8*)(pb0 + bj * bs + (kb) + 32 * kk); B_[kk][bj][1] = *(const bf16x8*)(pb1 + bj * bs + (kb) + 32 * kk); } } } while (0)
#define SK_MMA(A_, B_) do { _Pragma("unroll") for (int kk = 0; kk < 2; ++kk) _Pragma("unroll") for (int bj = 0; bj < 2; ++bj) _Pragma("unroll") for (int m = 0; m < 4; ++m) _Pragma("unroll") for (int n = 0; n < 2; ++n) \
        acc[AI][bj][m][n] = __builtin_amdgcn_mfma_f32_16x16x32_bf16(B_[kk][bj][n], A_[kk][m], acc[AI][bj][m][n], 0, 0, 0); } while (0)
#pragma unroll 1
    for (int k = kbeg; k < kend; k += 128) {
        SK_LOAD(a0, b0, k);
        SK_LOAD(a1, b1, k + 64);
        SK_MMA(a0, b0);
        SK_MMA(a1, b1);
    }
#undef SK_LOAD
#undef SK_MMA
    if (wave > 0) {
#pragma unroll
        for (int bj = 0; bj < 2; ++bj)
#pragma unroll
            for (int m = 0; m < 4; ++m)
#pragma unroll
                for (int n = 0; n < 2; ++n) *(LAS f32x4*)(lds + (((wave - 1) * 16 + bj * 8 + m * 2 + n) * 64 + lane) * 16) = acc[AI][bj][m][n];
    }
    __syncthreads();
    if (wave == 0) {
#pragma unroll 1
        for (int w = 0; w < 7; ++w) {
#pragma unroll
            for (int bj = 0; bj < 2; ++bj)
#pragma unroll
                for (int m = 0; m < 4; ++m)
#pragma unroll
                    for (int n = 0; n < 2; ++n) acc[AI][bj][m][n] += *(const LAS f32x4*)(lds + ((w * 16 + bj * 8 + m * 2 + n) * 64 + lane) * 16);
        }
        E.template run<AI, AI + 1>(acc, u, wr, wc, fr, fq);
    }
    __syncthreads();
}
template <class Epi>
__device__ __forceinline__ void skinny_ctx(LAS unsigned char* lds, const Gemm g, const Epi& E, int nN, int first, int stride, int wave, int lane) {
    const int nitems = 2 * nN * 16;
    for (int it = first; it < nitems; it += stride) {
        const int un = it >> 4, sub = it & 15;
        Unit u; u.pm = 64 + (un & 1); u.pn = un >> 1;
        const int wr = (sub >> 2) & 1, wc = sub & 3;
        if (sub & 8) skinny_item<Epi, 1>(lds, g, E, u, wr, wc, wave, lane); else skinny_item<Epi, 0>(lds, g, E, u, wr, wc, wave, lane);
    }
}
}

constexpr int KROW = 208, VROW = 144, KBUF = 64 * KROW, VBUF = 64 * VROW;
__device__ __forceinline__ float max2f(float a, float b) { return __builtin_fmaxf(a, b); }
__device__ __forceinline__ float max3f(float a, float b, float c) { float r; asm("v_max3_f32 %0, %1, %2, %3" : "=v"(r) : "v"(a), "v"(b), "v"(c)); return r; }
__device__ __forceinline__ float xhalf_max(float m) { auto rr = __builtin_amdgcn_permlane32_swap(__float_as_uint(m), __float_as_uint(m), false, false); return max2f(__uint_as_float(rr[0]), __uint_as_float(rr[1])); }
__device__ __forceinline__ float xhalf_sum(float m) { auto rr = __builtin_amdgcn_permlane32_swap(__float_as_uint(m), __float_as_uint(m), false, false); return __uint_as_float(rr[0]) + __uint_as_float(rr[1]); }

__device__ __forceinline__ void attn_unit(LAS unsigned char* lds, const bf16_t* __restrict__ Q, const bf16_t* __restrict__ KN, const bf16_t* __restrict__ KPE,
                                          const bf16_t* __restrict__ VT, bf16_t* __restrict__ MIX, int b, int h, int qrow0, int ntiles, const int tid_in) {
    int tid = tid_in; asm volatile("" : "+v"(tid));
    const int lane = tid & 63, r32 = lane & 31, hi = lane >> 5, wid = __builtin_amdgcn_readfirstlane(tid >> 6);
    const bf16_t* qp = Q + (size_t)(qrow0 + wid * 32 + r32) * 768 + h * 96 + hi * 8;
    bf16x8 qf[6];
#pragma unroll
    for (int ds = 0; ds < 6; ++ds) qf[ds] = *(const bf16x8*)(qp + ds * 16);
    const int kkey = tid >> 3, kc = tid & 7, pkey = (tid >> 2) & 63, pc = tid & 3;
    const bf16_t* knp = KN + (size_t)kkey * 512 + h * 64 + kc * 8;
    const bf16_t* kpp = KPE + (size_t)pkey * 32 + pc * 8;
    const bf16_t* vtp = VT + (size_t)(h * 64 + kkey) * MT + kc * 8;
    const int kw_off = kkey * KROW + kc * 16, pw_off = pkey * KROW + 128 + pc * 16, vw_off = KBUF + kkey * VROW + kc * 16;
    const int pi = (r32 & 0x13) | ((r32 & 4) << 1) | ((r32 & 8) >> 1);
    const int ka_off = pi * KROW + hi * 16, va_off = KBUF + r32 * VROW + hi * 16;
    constexpr int SLOT = KBUF + VBUF;
    u32x4 gk, gp, gv;
    gp = (u32x4){0u, 0u, 0u, 0u};
    bf16x8 kf[12], vf[8];
#define ROWBASE(kt) ((kt) < 4 ? (ML + 256 * b + 64 * (kt)) : (SEQ * b + 64 * ((kt) - 4)))
#define LOADT(kt) do { const int rb_ = ROWBASE(kt); gk = *(const u32x4*)(knp + (size_t)rb_ * 512); if (tid < 256) gp = *(const u32x4*)(kpp + (size_t)rb_ * 32); gv = *(const u32x4*)(vtp + rb_); } while (0)
#define STORET(so) do { *(LAS u32x4*)(lds + (so) + kw_off) = gk; if (tid < 256) *(LAS u32x4*)(lds + (so) + pw_off) = gp; *(LAS u32x4*)(lds + (so) + vw_off) = gv; } while (0)
#define LDK(so) do { _Pragma("unroll") for (int ds = 0; ds < 6; ++ds) { kf[2 * ds] = *(const LAS bf16x8*)(lds + (so) + ka_off + ds * 32); kf[2 * ds + 1] = *(const LAS bf16x8*)(lds + (so) + ka_off + 32 * KROW + ds * 32); } } while (0)
#define LDV(so) do { _Pragma("unroll") for (int st = 0; st < 4; ++st) { vf[2 * st] = *(const LAS bf16x8*)(lds + (so) + va_off + st * 32); vf[2 * st + 1] = *(const LAS bf16x8*)(lds + (so) + va_off + 32 * VROW + st * 32); } } while (0)
    LOADT(0); STORET(0);
    LOADT(1); STORET(SLOT);
    __syncthreads();
    LDK(0);
    int sc = 0, sn = SLOT, snn = 2 * SLOT;
    f32x16 o0 = {}, o1 = {}, o2 = {}, negm = {};
    float mref = 0.f;
    const short one_b = (r32 == 0) ? (short)0x3f80 : (short)0;
    const bf16x8 ones = (bf16x8){one_b, one_b, one_b, one_b, one_b, one_b, one_b, one_b};
    for (int t = 0; t < ntiles; ++t) {
        if (t + 2 < ntiles) LOADT(t + 2);
        LDV(sc);
        __builtin_amdgcn_sched_barrier(0);
        f32x16 s0 = negm, s1 = negm;
#pragma unroll
        for (int ds = 0; ds < 6; ++ds) {
            s0 = __builtin_amdgcn_mfma_f32_32x32x16_bf16(kf[2 * ds], qf[ds], s0, 0, 0, 0);
            s1 = __builtin_amdgcn_mfma_f32_32x32x16_bf16(kf[2 * ds + 1], qf[ds], s1, 0, 0, 0);
        }
        __builtin_amdgcn_sched_barrier(0);
        float m4[4];
#pragma unroll
        for (int c = 0; c < 4; ++c) m4[c] = max2f(s0[c], s1[c]);
#pragma unroll
        for (int r = 4; r < 16; ++r) m4[r & 3] = max2f(max2f(m4[r & 3], s0[r]), s1[r]);
        float mx = max2f(max2f(m4[0], m4[1]), max2f(m4[2], m4[3]));
        mx = xhalf_max(mx);
        if (t == 0 || __any(mx > 8.0f)) {
            const float d = (t == 0) ? mx : max2f(mx, 0.f);
            mref += d;
#pragma unroll
            for (int r = 0; r < 16; ++r) { s0[r] -= d; s1[r] -= d; negm[r] = -mref; }
            const float f = (t == 0) ? 1.0f : __builtin_amdgcn_exp2f(-d);
            o2[0] *= f;
#pragma unroll
            for (int r = 0; r < 16; ++r) { o0[r] *= f; o1[r] *= f; }
        }
#pragma unroll
        for (int r = 0; r < 16; ++r) { s0[r] = __builtin_amdgcn_exp2f(s0[r]); s1[r] = __builtin_amdgcn_exp2f(s1[r]); }
        u32x4 pw[4];
#pragma unroll
        for (int j = 0; j < 4; ++j) { pw[0][j] = cvt_pk_bf16(s0[2 * j], s0[2 * j + 1]); pw[1][j] = cvt_pk_bf16(s0[8 + 2 * j], s0[8 + 2 * j + 1]);
                                      pw[2][j] = cvt_pk_bf16(s1[2 * j], s1[2 * j + 1]); pw[3][j] = cvt_pk_bf16(s1[8 + 2 * j], s1[8 + 2 * j + 1]); }
        __builtin_amdgcn_sched_barrier(0);
        if (t + 1 < ntiles) LDK(sn);
#pragma unroll
        for (int st = 0; st < 4; ++st) {
            const bf16x8 pf = __builtin_bit_cast(bf16x8, pw[st]);
            o0 = __builtin_amdgcn_mfma_f32_32x32x16_bf16(vf[2 * st], pf, o0, 0, 0, 0);
            o1 = __builtin_amdgcn_mfma_f32_32x32x16_bf16(vf[2 * st + 1], pf, o1, 0, 0, 0);
            o2 = __builtin_amdgcn_mfma_f32_32x32x16_bf16(ones, pf, o2, 0, 0, 0);
        }
        __builtin_amdgcn_sched_barrier(0);
        if (t + 2 < ntiles) STORET(snn);
        __syncthreads();
        { const int tmp = sc; sc = sn; sn = snn; snn = tmp; }
    }
#undef ROWBASE
#undef LOADT
#undef STORET
#undef LDK
#undef LDV
    const float inv = __builtin_amdgcn_rcpf(xhalf_sum(hi == 0 ? o2[0] : 0.f));
    bf16_t* op = MIX + (size_t)(qrow0 + wid * 32 + r32) * DM + h * 64 + 4 * hi;
#pragma unroll
    for (int g = 0; g < 4; ++g) {
        u32x2 w0, w1;
        w0.x = cvt_pk_bf16(o0[4 * g] * inv, o0[4 * g + 1] * inv); w0.y = cvt_pk_bf16(o0[4 * g + 2] * inv, o0[4 * g + 3] * inv);
        w1.x = cvt_pk_bf16(o1[4 * g] * inv, o1[4 * g + 1] * inv); w1.y = cvt_pk_bf16(o1[4 * g + 2] * inv, o1[4 * g + 3] * inv);
        *(u32x2*)(op + 8 * g) = w0; *(u32x2*)(op + 32 + 8 * g) = w1;
    }
}

__device__ __forceinline__ void attn_unit2(LAS unsigned char* lds, const bf16_t* __restrict__ Q, const bf16_t* __restrict__ KN, const bf16_t* __restrict__ KPE,
                                           const bf16_t* __restrict__ VT, bf16_t* __restrict__ MIX, int b, int h, int qrow0, int ntiles, const int tid_in) {
    int tid = tid_in; asm volatile("" : "+v"(tid));
    const int lane = tid & 63, r32 = lane & 31, hi = lane >> 5, wid = __builtin_amdgcn_readfirstlane(tid >> 6);
    const bf16_t* qp = Q + (size_t)(qrow0 + wid * 64 + r32) * 768 + h * 96 + hi * 8;
    bf16x8 qa[6], qb[6];
#pragma unroll
    for (int ds = 0; ds < 6; ++ds) { qa[ds] = *(const bf16x8*)(qp + ds * 16); qb[ds] = *(const bf16x8*)(qp + (size_t)32 * 768 + ds * 16); }
    const int pi = (r32 & 0x13) | ((r32 & 4) << 1) | ((r32 & 8) >> 1);
    const int ka_off = pi * KROW + hi * 16, va_off = KBUF + r32 * VROW + hi * 16;
    constexpr int SLOT = KBUF + VBUF;
    const char* dsrc[3]; unsigned dmul[3]; int dlds[3];
#pragma unroll
    for (int r = 0; r < 3; ++r) {
        const int ii = wid + 8 * r;
        if (ii < 13) {
            const int p = 64 * ii + lane, row = p / 13, cc = p % 13;
            if (cc >= 8 && cc < 12) { dsrc[r] = (const char*)(KPE + (size_t)row * 32 + 8 * (cc - 8)); dmul[r] = 64u; }
            else { dsrc[r] = (const char*)(KN + (size_t)row * 512 + h * 64 + 8 * (cc == 12 ? 0 : cc)); dmul[r] = 1024u; }
            dlds[r] = 1024 * ii;
        } else {
            const int p = 64 * (ii - 13) + lane, d = p / 9, cc = p % 9;
            dsrc[r] = (const char*)(VT + (size_t)(h * 64 + (d < 64 ? d : 63)) * MT + 8 * (cc == 8 ? 0 : cc)); dmul[r] = 2u;
            dlds[r] = KBUF + 1024 * (ii - 13);
        }
    }
#define ROWBASE(kt) ((kt) < 4 ? (ML + 256 * b + 64 * (kt)) : (SEQ * b + 64 * ((kt) - 4)))
#define DMAT(kt, so) do { const unsigned rb_ = (unsigned)ROWBASE(kt); _Pragma("unroll") for (int r = 0; r < 3; ++r) if (wid + 8 * r < 22) \
        __builtin_amdgcn_global_load_lds((const unsigned*)(dsrc[r] + (size_t)rb_ * dmul[r]), (LAS unsigned*)(lds + (so) + dlds[r]), 16, 0, 0); } while (0)
    DMAT(0, 0);
    DMAT(1, SLOT);
    __syncthreads();
    int sc = 0, sn = SLOT, snn = 2 * SLOT;
    f32x16 oa0 = {}, oa1 = {}, ob0 = {}, ob1 = {};
    float ma = -1.0e30f, mb = -1.0e30f, la = 0.f, lb = 0.f;
    for (int t = 0; t < ntiles; ++t) {
        __builtin_amdgcn_sched_barrier(0);
        f32x16 sa0 = {}, sa1 = {}, sb0 = {}, sb1 = {};
        const LAS unsigned char* ka = lds + sc + ka_off;
#pragma unroll
        for (int ds = 0; ds < 6; ++ds) {
            const bf16x8 k0 = *(const LAS bf16x8*)(ka + ds * 32);
            const bf16x8 k1 = *(const LAS bf16x8*)(ka + 32 * KROW + ds * 32);
            sa0 = __builtin_amdgcn_mfma_f32_32x32x16_bf16(k0, qa[ds], sa0, 0, 0, 0);
            sa1 = __builtin_amdgcn_mfma_f32_32x32x16_bf16(k1, qa[ds], sa1, 0, 0, 0);
            sb0 = __builtin_amdgcn_mfma_f32_32x32x16_bf16(k0, qb[ds], sb0, 0, 0, 0);
            sb1 = __builtin_amdgcn_mfma_f32_32x32x16_bf16(k1, qb[ds], sb1, 0, 0, 0);
        }
        __builtin_amdgcn_sched_barrier(0);
        if (t + 2 < ntiles) DMAT(t + 2, snn);
        u32x4 pa[4], pb[4];
#define SOFTMAX2(S0, S1, MREF, LSUM, O0, O1, PW) do { \
        float m4[4]; \
        _Pragma("unroll") for (int c = 0; c < 4; ++c) m4[c] = max2f(S0[c], S1[c]); \
        _Pragma("unroll") for (int r = 4; r < 16; ++r) m4[r & 3] = max2f(max2f(m4[r & 3], S0[r]), S1[r]); \
        float mx = xhalf_max(max2f(max2f(m4[0], m4[1]), max2f(m4[2], m4[3]))); \
        if (__any(mx - MREF > 8.0f)) { \
            const float mnew = max2f(mx, MREF); \
            const float f = __builtin_amdgcn_exp2f(MREF - mnew); \
            MREF = mnew; LSUM *= f; \
            _Pragma("unroll") for (int r = 0; r < 16; ++r) { O0[r] *= f; O1[r] *= f; } \
        } \
        float ps = 0.f; \
        _Pragma("unroll") for (int r = 0; r < 16; ++r) { S0[r] = __builtin_amdgcn_exp2f(S0[r] - MREF); S1[r] = __builtin_amdgcn_exp2f(S1[r] - MREF); ps += S0[r] + S1[r]; } \
        LSUM += ps; \
        _Pragma("unroll") for (int j = 0; j < 4; ++j) { PW[0][j] = cvt_pk_bf16(S0[2 * j], S0[2 * j + 1]); PW[1][j] = cvt_pk_bf16(S0[8 + 2 * j], S0[8 + 2 * j + 1]); \
                                                        PW[2][j] = cvt_pk_bf16(S1[2 * j], S1[2 * j + 1]); PW[3][j] = cvt_pk_bf16(S1[8 + 2 * j], S1[8 + 2 * j + 1]); } \
    } while (0)
        SOFTMAX2(sa0, sa1, ma, la, oa0, oa1, pa);
        SOFTMAX2(sb0, sb1, mb, lb, ob0, ob1, pb);
#undef SOFTMAX2
        const LAS unsigned char* va = lds + sc + va_off;
#pragma unroll
        for (int st = 0; st < 4; ++st) {
            const bf16x8 v0 = *(const LAS bf16x8*)(va + st * 32);
            const bf16x8 v1 = *(const LAS bf16x8*)(va + 32 * VROW + st * 32);
            const bf16x8 fa = __builtin_bit_cast(bf16x8, pa[st]), fb = __builtin_bit_cast(bf16x8, pb[st]);
            oa0 = __builtin_amdgcn_mfma_f32_32x32x16_bf16(v0, fa, oa0, 0, 0, 0);
            oa1 = __builtin_amdgcn_mfma_f32_32x32x16_bf16(v1, fa, oa1, 0, 0, 0);
            ob0 = __builtin_amdgcn_mfma_f32_32x32x16_bf16(v0, fb, ob0, 0, 0, 0);
            ob1 = __builtin_amdgcn_mfma_f32_32x32x16_bf16(v1, fb, ob1, 0, 0, 0);
        }
        __builtin_amdgcn_sched_barrier(0);
        __syncthreads();
        { const int tmp = sc; sc = sn; sn = snn; snn = tmp; }
    }
#undef ROWBASE
#undef DMAT
    const float inva = __builtin_amdgcn_rcpf(xhalf_sum(la)), invb = __builtin_amdgcn_rcpf(xhalf_sum(lb));
    bf16_t* op = MIX + (size_t)(qrow0 + wid * 64 + r32) * DM + h * 64 + 4 * hi;
#pragma unroll
    for (int g = 0; g < 4; ++g) {
        u32x2 w0, w1;
        w0.x = cvt_pk_bf16(oa0[4 * g] * inva, oa0[4 * g + 1] * inva); w0.y = cvt_pk_bf16(oa0[4 * g + 2] * inva, oa0[4 * g + 3] * inva);
        w1.x = cvt_pk_bf16(oa1[4 * g] * inva, oa1[4 * g + 1] * inva); w1.y = cvt_pk_bf16(oa1[4 * g + 2] * inva, oa1[4 * g + 3] * inva);
        *(u32x2*)(op + 8 * g) = w0; *(u32x2*)(op + 32 + 8 * g) = w1;
        w0.x = cvt_pk_bf16(ob0[4 * g] * invb, ob0[4 * g + 1] * invb); w0.y = cvt_pk_bf16(ob0[4 * g + 2] * invb, ob0[4 * g + 3] * invb);
        w1.x = cvt_pk_bf16(ob1[4 * g] * invb, ob1[4 * g + 1] * invb); w1.y = cvt_pk_bf16(ob1[4 * g + 2] * invb, ob1[4 * g + 3] * invb);
        *(u32x2*)(op + (size_t)32 * DM + 8 * g) = w0; *(u32x2*)(op + (size_t)32 * DM + 32 + 8 * g) = w1;
    }
}

enum { MAP_ID = 0, MAP_SWIGLU, MAP_WIN, MAP_UPQ, MAP_UPK, MAP_VT };
__device__ __forceinline__ int lmap(int p) { const int fq = p >> 3, nn = (p >> 2) & 1, j = p & 3; return 16 * (fq >> 1) + 8 * nn + 4 * (fq & 1) + j; }
template <int MAP> __device__ __forceinline__ int map_col(int n) {
    if (MAP == MAP_ID) return n;
    if (MAP == MAP_SWIGLU) { const int t = n >> 8, bj = (n >> 7) & 1, i = n & 127; return bj * DFF + 128 * t + i; }
    if (MAP == MAP_WIN) { if (n >= DIN) return -1; if (n >= 384 && n < 416) return 384 + lmap(n - 384); return n; }
    if (MAP == MAP_UPQ) { const int hh = n / 96, r = n % 96; return r < 64 ? n : hh * 96 + 64 + lmap(r - 64); }
    if (MAP == MAP_UPK) return (n >> 6) * 128 + (n & 63);
    return (n >> 6) * 128 + 64 + (n & 63);
}
template <int MAP> __device__ __forceinline__ void tr_item(const float* __restrict__ W, int Nsrc, const float* __restrict__ kscale, bf16_t* __restrict__ dst, int ldd, int kdst0, int nblk,
                                                           LAS float* scr, int item, int lane) {
    const int kb = item / nblk, nb = item % nblk, k0 = 64 * kb, n0 = 32 * nb;
    const int q4 = lane & 7, kr = lane >> 3;
    const int src = map_col<MAP>(n0 + 4 * q4);
    f32x4 tv[8];
#pragma unroll
    for (int i = 0; i < 8; ++i) { const int kk = 8 * i + kr; tv[i] = (src >= 0) ? *(const f32x4*)(W + (size_t)(k0 + kk) * Nsrc + src) : (f32x4){0.f, 0.f, 0.f, 0.f}; }
#pragma unroll
    for (int i = 0; i < 8; ++i) { const int kk = 8 * i + kr; f32x4 v = tv[i]; if (kscale) v = v * kscale[k0 + kk];
        scr[kk * 33 + 4 * q4 + 0] = v.x; scr[kk * 33 + 4 * q4 + 1] = v.y; scr[kk * 33 + 4 * q4 + 2] = v.z; scr[kk * 33 + 4 * q4 + 3] = v.w; }
    asm volatile("s_waitcnt lgkmcnt(0)" ::: "memory");
    const int c = lane & 7;
#pragma unroll
    for (int j = 0; j < 4; ++j) { const int n = (lane >> 3) + 8 * j; const LAS float* s = scr + (8 * c) * 33 + n;
        u32x4 o; o.x = cvt_pk_bf16(s[0 * 33], s[1 * 33]); o.y = cvt_pk_bf16(s[2 * 33], s[3 * 33]); o.z = cvt_pk_bf16(s[4 * 33], s[5 * 33]); o.w = cvt_pk_bf16(s[6 * 33], s[7 * 33]);
        *(u32x4*)(dst + (size_t)(n0 + n) * ldd + kdst0 + k0 + 8 * c) = o; }
    asm volatile("s_waitcnt lgkmcnt(0)" ::: "memory");
}

struct Args { const float* in[19]; float* out; unsigned char* ws; int ph_lo, ph_hi; };

__global__ void __launch_bounds__(512, 2) mega_fwd(Args a_byval) {
    extern __shared__ __attribute__((aligned(16))) unsigned char lds_raw[];
    cg::grid_group grid = cg::this_grid();
    const int ph_lo = a_byval.ph_lo, ph_hi = a_byval.ph_hi;
    const int wave0 = __builtin_amdgcn_readfirstlane((int)threadIdx.x >> 6);
    const int it_hi = ph_hi + (PROBE_DUP >= 0 ? 1 : 0);
    for (int it = ph_lo; it < it_hi; ++it) {
    const int ph = (PROBE_DUP >= 0 && it > PROBE_DUP) ? it - 1 : it;
    const __attribute__((address_space(4))) unsigned char* kap = (const __attribute__((address_space(4))) unsigned char*)__builtin_amdgcn_kernarg_segment_ptr();
    asm volatile("" : "+s"(kap));
    const __attribute__((address_space(4))) Args& a = *(const __attribute__((address_space(4))) Args*)kap;
    LAS unsigned char* lds = (LAS unsigned char*)lds_raw;
    const int wave = wave0;
    int G = gridDim.x, bx = blockIdx.x; asm volatile("" : "+s"(G), "+s"(bx));
    const int vcu = (G % 8 == 0) ? (bx % 8) * (G / 8) + bx / 8 : bx;
    const int gw = vcu * 8 + wave, NGW = G * 8;
    const int gwm = wave * G + vcu;
    unsigned char* ws = a.ws;
    float* mod = (float*)(ws + WS_MOD);
    float* rope = (float*)(ws + WS_ROPE);
    float* sWall = (float*)(ws + WS_SW);
    float* ssqp = (float*)(ws + WS_SSQP);
    float* ssqq = (float*)(ws + WS_SSQQ);
    float* ssqkv = (float*)(ws + WS_SSQKV);
    float* xctx = (float*)(ws + WS_XCTX);
    bf16_t* Xw = (bf16_t*)(ws + WS_XW);
    bf16_t* Qb = (bf16_t*)(ws + WS_XW);
    bf16_t* Hb = (bf16_t*)(ws + WS_H);
    bf16_t* Pb = (bf16_t*)(ws + WS_P);
    bf16_t* KNb = (bf16_t*)(ws + WS_KN);
    bf16_t* KPEb = (bf16_t*)(ws + WS_KPE);
    bf16_t* VTb = (bf16_t*)(ws + WS_VT);
    bf16_t* MIXb = (bf16_t*)(ws + WS_MIX);
    const float* x_in = a.in[0]; const float* ctx_in = a.in[2];
    const float* norm_w = a.in[6];
    {
        if (ph == 0) {
            const int lane = fresh_lane(); const int tid = wave0 * 64 + lane; (void)tid; (void)lane;
            LAS float* scr = (LAS float*)(lds + wave * 16384);
            constexpr int I1 = 2816, I2 = 1408, I5 = 1024, I6 = 96, I8 = 32, I12 = 512;
            constexpr int PER_L = 2 * I1 + 2 * I2 + I5 + I6 + 2 * I8 + I12;
            constexpr int N_TR = 2 * PER_L, N_ADA = 2 * 144 * 8, N_ALL = N_TR + N_ADA + 1;
            for (int it = gw; it < N_ALL; it += NGW) {
                if (it < N_TR) {
                    const int l = it / PER_L; int r = it % PER_L;
                    unsigned char* wl = ws + WS_W + (size_t)l * W_L;
                    unsigned char* wu = ws + WS_WUP + (size_t)l * WUP_L;
                    if (r < I1) { tr_item<MAP_SWIGLU>(a.in[7] + (size_t)l * DM * NFF, NFF, nullptr, (bf16_t*)(wl + W_1IN), DM, 0, NFF / 32, scr, r, lane); continue; } r -= I1;
                    if (r < I2) { tr_item<MAP_ID>(a.in[8] + (size_t)l * DFF * DM, DM, nullptr, (bf16_t*)(wl + W_1OUT), DFF, 0, DM / 32, scr, r, lane); continue; } r -= I2;
                    if (r < I1) { tr_item<MAP_SWIGLU>(a.in[9] + (size_t)l * DM * NFF, NFF, nullptr, (bf16_t*)(wl + W_2IN), DM, 0, NFF / 32, scr, r, lane); continue; } r -= I1;
                    if (r < I2) { tr_item<MAP_ID>(a.in[10] + (size_t)l * DFF * DM, DM, nullptr, (bf16_t*)(wl + W_2OUT), DFF, 0, DM / 32, scr, r, lane); continue; } r -= I2;
                    if (r < I5) { tr_item<MAP_WIN>(a.in[11] + (size_t)l * DM * DIN, DIN, nullptr, (bf16_t*)(wl + W_IN), DM, 0, DINP / 32, scr, r, lane); continue; } r -= I5;
                    if (r < I6) { tr_item<MAP_UPQ>(a.in[14] + (size_t)l * 256 * 768, 768, a.in[12] + l * 256, (bf16_t*)wu, KUP, 0, 768 / 32, scr, r, lane); continue; } r -= I6;
                    if (r < I8) { tr_item<MAP_UPK>(a.in[15] + (size_t)l * 128 * 1024, 1024, a.in[13] + l * 128, (bf16_t*)wu + 768 * KUP, KUP, 256, 512 / 32, scr, r, lane); continue; } r -= I8;
                    if (r < I8) { tr_item<MAP_VT>(a.in[15] + (size_t)l * 128 * 1024, 1024, a.in[13] + l * 128, (bf16_t*)(wu + WUP_VT), KUP, 256, 512 / 32, scr, r, lane); continue; } r -= I8;
                    tr_item<MAP_ID>(a.in[17] + (size_t)l * DM * DM, DM, nullptr, (bf16_t*)(wl + W_OUT), DM, 0, DM / 32, scr, r, lane);
                } else if (it < N_TR + N_ADA) {
                    int r = it - N_TR; const int l = r / 1152; r %= 1152; const int cgp = r >> 3, kc = r & 7, j = 64 * cgp + lane, k0 = 128 * kc;
#pragma unroll
                    for (int i2 = 0; i2 < 2; ++i2) { const int k = k0 + lane + 64 * i2; const float c0 = a.in[1][k], c1 = a.in[1][DM + k], c2 = a.in[3][k];
                        scr[lane + 64 * i2] = c0 / (1.0f + __expf(-c0)); scr[128 + lane + 64 * i2] = c1 / (1.0f + __expf(-c1)); scr[256 + lane + 64 * i2] = c2 / (1.0f + __expf(-c2)); }
                    asm volatile("s_waitcnt lgkmcnt(0)" ::: "memory");
                    float a0 = 0.f, a1 = 0.f, a2 = 0.f;
                    const float* wp = a.in[4] + ((size_t)l * DM + k0) * NMOD + j;
                    for (int kb = 0; kb < 128; kb += 32) {
                        float wv[32];
#pragma unroll
                        for (int kk = 0; kk < 32; ++kk) wv[kk] = wp[(size_t)(kb + kk) * NMOD];
#pragma unroll
                        for (int kk = 0; kk < 32; ++kk) { a0 += scr[kb + kk] * wv[kk]; a1 += scr[128 + kb + kk] * wv[kk]; a2 += scr[256 + kb + kk] * wv[kk]; }
                    }
                    if (kc == 0) { const float bb = a.in[5][l * NMOD + j]; a0 += bb; a1 += bb; a2 += bb; }
                    atomicAdd(mod + (size_t)(l * 3 + 0) * NMOD + j, a0); atomicAdd(mod + (size_t)(l * 3 + 1) * NMOD + j, a1); atomicAdd(mod + (size_t)(l * 3 + 2) * NMOD + j, a2);
                    asm volatile("s_waitcnt lgkmcnt(0)" ::: "memory");
                } else {
                    for (int e = lane; e < 1024; e += 64) {
                        const int pos = e >> 3, i = e & 7;
                        float th = (i & 1) ? 0.31622776601683794f : 1.0f;
                        for (int q = 0; q < (i >> 1); ++q) th *= 0.1f;
                        const float x2 = th * th;
                        const float c1 = 1.0f + x2 * (-0.5f + x2 * (4.1666666666666664e-2f + x2 * (-1.3888888888888889e-3f + x2 * (2.4801587301587302e-5f + x2 * (-2.7557319223985888e-7f + x2 * 2.08767569878681e-9f)))));
                        const float s1 = th * (1.0f + x2 * (-1.6666666666666666e-1f + x2 * (8.3333333333333332e-3f + x2 * (-1.9841269841269841e-4f + x2 * (2.7557319223985893e-6f + x2 * (-2.505210838544172e-8f + x2 * 1.6059043836821613e-10f))))));
                        float c = 1.0f, sn = 0.0f;
                        for (int bit = 6; bit >= 0; --bit) {
                            const float c2 = c * c - sn * sn, s2 = 2.0f * c * sn; c = c2; sn = s2;
                            if ((pos >> bit) & 1) { const float c3 = c * c1 - sn * s1, s3 = sn * c1 + c * s1; c = c3; sn = s3; }
                        }
                        rope[2 * e] = c; rope[2 * e + 1] = sn;
                    }
                }
            }
        } else if (ph == 1) {
            const int lane = fresh_lane(); const int tid = wave0 * 64 + lane; (void)tid; (void)lane;
            constexpr int N_SW = 2 * 832, N_X4 = MT / 4;
            for (int it = gw; it < N_SW + N_X4; it += NGW) {
                if (it < N_SW) {
                    const int l = it / 832; int r = it % 832;
                    const bf16_t* Bt; int chunk, N, n0; float* outp;
                    unsigned char* wl = ws + WS_W + (size_t)l * W_L;
                    if (r < 352) { Bt = (const bf16_t*)(wl + W_1IN); chunk = 0; N = NFF; n0 = 16 * r; outp = sWall + l * SW_L; }
                    else if (r < 704) { Bt = (const bf16_t*)(wl + W_2IN); chunk = 6; N = NFF; n0 = 16 * (r - 352); outp = sWall + l * SW_L + 3 * NFF; }
                    else { Bt = (const bf16_t*)(wl + W_IN); chunk = 3; N = DINP; n0 = 16 * (r - 704); outp = sWall + l * SW_L + 6 * NFF; }
                    f32x4 sh[3][4];
#pragma unroll
                    for (int s = 0; s < 3; ++s)
#pragma unroll
                        for (int q = 0; q < 4; ++q) sh[s][q] = *(const f32x4*)(mod + (size_t)(l * 3 + s) * NMOD + chunk * DM + 16 * lane + 4 * q);
#pragma unroll 1
                    for (int r4 = 0; r4 < 16; r4 += 4) {
                        u32x4 w0[4], w1[4];
#pragma unroll
                        for (int j = 0; j < 4; ++j) { w0[j] = *(const u32x4*)(Bt + (size_t)(n0 + r4 + j) * DM + 16 * lane); w1[j] = *(const u32x4*)(Bt + (size_t)(n0 + r4 + j) * DM + 16 * lane + 8); }
                        float d[4][3];
#pragma unroll
                        for (int j = 0; j < 4; ++j) {
                            const f32x4 f0 = (f32x4){bf_lo(w0[j].x), bf_hi(w0[j].x), bf_lo(w0[j].y), bf_hi(w0[j].y)}, f1 = (f32x4){bf_lo(w0[j].z), bf_hi(w0[j].z), bf_lo(w0[j].w), bf_hi(w0[j].w)};
                            const f32x4 f2 = (f32x4){bf_lo(w1[j].x), bf_hi(w1[j].x), bf_lo(w1[j].y), bf_hi(w1[j].y)}, f3 = (f32x4){bf_lo(w1[j].z), bf_hi(w1[j].z), bf_lo(w1[j].w), bf_hi(w1[j].w)};
#pragma unroll
                            for (int s = 0; s < 3; ++s) d[j][s] = sum4(f0 * sh[s][0] + f1 * sh[s][1] + f2 * sh[s][2] + f3 * sh[s][3]);
                        }
#pragma unroll
                        for (int o = 1; o < 64; o <<= 1)
#pragma unroll
                            for (int j = 0; j < 4; ++j)
#pragma unroll
                                for (int s = 0; s < 3; ++s) d[j][s] += shx(d[j][s], o, lane);
                        if (lane == 0) {
#pragma unroll
                            for (int j = 0; j < 4; ++j) { outp[n0 + r4 + j] = d[j][0]; outp[N + n0 + r4 + j] = d[j][1]; outp[2 * N + n0 + r4 + j] = d[j][2]; }
                        }
                    }
                } else {
                    const int m0 = 4 * (it - N_SW); const int s = m0 < SEQ ? 0 : (m0 < ML ? 1 : 2);
                    const float* src = m0 < ML ? x_in + (size_t)m0 * DM : ctx_in + (size_t)(m0 - ML) * DM;
                    f32x4 v[4][4], wm[4];
#pragma unroll
                    for (int rr = 0; rr < 4; ++rr)
#pragma unroll
                        for (int j = 0; j < 4; ++j) v[rr][j] = *(const f32x4*)(src + (size_t)rr * DM + 4 * lane + 256 * j);
#pragma unroll
                    for (int j = 0; j < 4; ++j) { const int col = 4 * lane + 256 * j; wm[j] = (*(const f32x4*)(norm_w + col)) * (*(const f32x4*)(mod + (size_t)s * NMOD + DM + col) + 1.0f); }
                    float q[4];
#pragma unroll
                    for (int rr = 0; rr < 4; ++rr) {
                        q[rr] = (dot4(v[rr][0]) + dot4(v[rr][1])) + (dot4(v[rr][2]) + dot4(v[rr][3]));
#pragma unroll
                        for (int j = 0; j < 4; ++j) { const f32x4 y = v[rr][j] * wm[j]; u32x2 w; w.x = cvt_pk_bf16(y.x, y.y); w.y = cvt_pk_bf16(y.z, y.w); *(u32x2*)(Xw + (size_t)(m0 + rr) * DM + 4 * lane + 256 * j) = w; }
                    }
#pragma unroll
                    for (int o = 1; o < 64; o <<= 1)
#pragma unroll
                        for (int rr = 0; rr < 4; ++rr) q[rr] += shx(q[rr], o, lane);
                    const float qsel = (lane >> 4) == 0 ? q[0] : ((lane >> 4) == 1 ? q[1] : ((lane >> 4) == 2 ? q[2] : q[3]));
                    ssqp[(size_t)m0 * 16 + lane] = (lane & 15) == 0 ? qsel : 0.f;
                }
            }
        } else if (ph == 18) {
            const int lane = fresh_lane(); const int tid = wave0 * 64 + lane; (void)tid; (void)lane;
            const float* fnw = a.in[18];
            for (int m = gw; m < ML; m += NGW) {
                const float t = wave_sum(lane < 16 ? ssqp[(size_t)m * 16 + lane] : 0.f, lane);
                const float rr = rsqrtf(t * (1.0f / 1024.0f) + EPS);
#pragma unroll
                for (int j = 0; j < 4; ++j) { const int col = 4 * lane + 256 * j; float* p = a.out + (size_t)m * DM + col; *(f32x4*)p = *(const f32x4*)p * rr * (*(const f32x4*)(fnw + col)); }
            }
        } else {
            const int l = (ph - 2) >> 3, k = (ph - 2) & 7;
            unsigned char* wl = ws + WS_W + (size_t)l * W_L;
            unsigned char* wu = ws + WS_WUP + (size_t)l * WUP_L;
            const float* modl = mod + (size_t)l * 3 * NMOD;
            float* sWl = sWall + l * SW_L;
            pg8::StaticOrder S;
            if (k == 0 || k == 6) {
                const int lane = fresh_lane(); const int tid = wave0 * 64 + lane; (void)tid; (void)lane;
                const int M = (l == 1 && k == 6) ? ML : MT;
                pg8::Gemm g{Xw, (const bf16_t*)(wl + (k == 0 ? W_1IN : W_2IN)), M, NFF, DM, DM, DM};
                const bool piped = (G == 256);
                unsigned* cntf = (unsigned*)(ws + WS_CNT) + (l * 2 + (k == 0 ? 0 : 1)) * 128;
                S.init(M, NFF, G, bx, 4, piped ? 1 : 0);
                pg8::EpiSwiglu E{Hb, ssqp, sWl + (k == 0 ? 0 : 3 * NFF), piped ? cntf : nullptr};
                pg8::gemm_phase<pg8::EpiSwiglu>(lds, g, S, E, tid);
            } else if (k == 1 || k == 7 || k == 5) {
                const int lane = fresh_lane(); const int tid = wave0 * 64 + lane; (void)tid; (void)lane;
                const int M = (l == 1 && k != 1) ? ML : MT;
                const bool kw = (k == 5), k1 = (k == 1);
                const bf16_t* gA = kw ? MIXb : Hb;
                const bf16_t* gB = (const bf16_t*)(wl + (kw ? W_OUT : (k1 ? W_1OUT : W_2OUT)));
                const int gK = kw ? DM : DFF;
                const float* xo_l = (k1 && l == 0) ? x_in : a.out;
                const float* xo_c = (k1 && l == 0) ? ctx_in : xctx;
                const float* gatep = modl + (kw ? 5 : (k1 ? 2 : 8)) * DM;
                const float* nwp = kw ? norm_w + (l * 3 + 2) * DM : (k1 ? norm_w + (l * 3 + 1) * DM : norm_w + 3 * DM);
                const float* nsp = kw ? modl + 7 * DM : (k1 ? modl + 4 * DM : mod + (size_t)3 * NMOD + DM);
                const bool has_ctx = (M == MT);
                const pg8::Gemm g{gA, gB, ML, DM, gK, gK, gK};
                const pg8::EpiResid E{xo_l, xo_c, a.out, xctx, gatep, nwp, nsp, Xw, ssqp, kw ? 1 : 0, (kw || k1 || l == 0) ? 1 : 0};
                const bool piped = (G == 256) && !kw;
                unsigned* cntf = (unsigned*)(ws + WS_CNT) + (l * 2 + (k1 ? 0 : 1)) * 128;
                if (piped) {
                    const int xq = bx & 7, tl = 31 - (bx >> 3), offp = (tl & 3) * 8 + (tl >> 2);
                    S.init(ML, DM, G, offp * 8 + xq);
                    pg8::Unit u0; S.next(0, u0);
                    if (tid == 0) {
                        unsigned spins = 0;
                        while (__hip_atomic_load(cntf + u0.pm, __ATOMIC_RELAXED, __HIP_MEMORY_SCOPE_AGENT) < 176u) { __builtin_amdgcn_s_sleep(8); if (++spins > (1u << 22)) break; }
                        __builtin_amdgcn_fence(__ATOMIC_ACQUIRE, "agent");
                        asm volatile("s_waitcnt vmcnt(0)" ::: "memory");
                    }
                    __syncthreads();
                } else S.init(ML, DM, G, bx);
                pg8::gemm_phase<pg8::EpiResid>(lds, g, S, E, tid);
                if (has_ctx) {
                    if (piped) {
                        const int offb = bx >> 3;
                        if (offb >= 24) {
                            if (wave0 == 0 && fresh_lane() == 0) {
                                unsigned spins = 0;
                                while (__hip_atomic_load(cntf + 64, __ATOMIC_RELAXED, __HIP_MEMORY_SCOPE_AGENT) < 176u || __hip_atomic_load(cntf + 65, __ATOMIC_RELAXED, __HIP_MEMORY_SCOPE_AGENT) < 176u) { __builtin_amdgcn_s_sleep(8); if (++spins > (1u << 22)) break; }
                                __builtin_amdgcn_fence(__ATOMIC_ACQUIRE, "agent");
                                asm volatile("s_waitcnt vmcnt(0)" ::: "memory");
                            }
                            __syncthreads();
                            pg8::skinny_ctx<pg8::EpiResid>(lds, g, E, DM / 256, (31 - offb) * 8 + (bx & 7), 64, wave0, fresh_lane());
                        }
                    } else pg8::skinny_ctx<pg8::EpiResid>(lds, g, E, DM / 256, bx, G, wave0, fresh_lane());
                }
            } else if (k == 2) {
                const int lane = fresh_lane(); const int tid = wave0 * 64 + lane; (void)tid; (void)lane;
                pg8::Gemm g{Xw, (const bf16_t*)(wl + W_IN), ML, DINP, DM, DM, DM};
                S.init(ML, DINP, G, bx);
                pg8::EpiInproj E{Pb, KPEb, ssqp, sWl + 6 * NFF, ssqq, ssqkv, rope};
                pg8::gemm_phase<pg8::EpiInproj>(lds, g, S, E, tid);
                pg8::skinny_ctx<pg8::EpiInproj>(lds, g, E, DINP / 256, bx, G, wave0, fresh_lane());
            } else if (k == 3) {
                const int tid = wave0 * 64 + fresh_lane();
                { pg8::Gemm g{Pb, (const bf16_t*)wu, MT, 768, 256, DINP, KUP};
                  S.init(MT, 768, G, bx);
                  pg8::EpiUpQK E{Qb, KNb, ssqq, ssqkv, rope, 0};
                  pg8::gemm_phase<pg8::EpiUpQK>(lds, g, S, E, tid); }
                { pg8::Gemm g{Pb + 256, (const bf16_t*)wu + (size_t)768 * KUP + 256, MT, 512, 128, DINP, KUP};
                  S.init(MT, 512, G, G - 1 - bx);
                  pg8::EpiUpQK E{Qb, KNb, ssqq, ssqkv, rope, 3};
                  pg8::gemm_phase<pg8::EpiUpQK>(lds, g, S, E, wave0 * 64 + fresh_lane()); }
                { pg8::Gemm g{(const bf16_t*)(wu + WUP_VT) + 256, Pb + 256, 512, MT, 128, KUP, DINP};
                  S.init(512, MT, G, (G != 256) ? bx : (bx < 124 ? bx : (bx >= 248 ? bx - 124 : 4096)));
                  pg8::EpiVT E{VTb, ssqkv};
                  pg8::gemm_phase<pg8::EpiVT>(lds, g, S, E, wave0 * 64 + fresh_lane()); }
                const int lane = fresh_lane();
                const float* cw = a.in[16] + (size_t)l * 3 * 512 + 8 * lane;
                float w0[8], w1[8], w2[8];
#pragma unroll
                for (int c = 0; c < 8; ++c) { w0[c] = cw[c]; w1[c] = cw[512 + c]; w2[c] = cw[1024 + c]; }
                const int nit = (l == 1) ? ML / 8 : MT / 8;
                for (int it = gw; it < nit; it += NGW) {
                    const int m0 = 8 * it; const int Lm = (m0 < ML) ? (SEQ - 1) : 255;
                    const bool first = (m0 & Lm) == 0, last = ((m0 + 8) & Lm) == 0;
                    const bf16_t* pr = Pb + (size_t)m0 * DINP + 8 * lane;
                    u32x4 gcr[10], xvr[10], gbr[8];
#pragma unroll
                    for (int i = 0; i < 10; ++i) {
                        const bool valid = (i == 0) ? !first : ((i == 9) ? !last : true);
                        const bf16_t* rp = pr + (ptrdiff_t)(i - 1) * DINP;
                        gcr[i] = valid ? *(const u32x4*)(rp + 928) : (u32x4){0u, 0u, 0u, 0u};
                        xvr[i] = valid ? *(const u32x4*)(rp + 1440) : (u32x4){0u, 0u, 0u, 0u};
                    }
#pragma unroll
                    for (int i = 0; i < 8; ++i) gbr[i] = *(const u32x4*)(pr + (size_t)i * DINP + 416);
                    float up[8], uc[8], un[8];
#define MKU(dst, g_, x_) do { dst[0] = bf_lo(g_.x) * bf_lo(x_.x); dst[1] = bf_hi(g_.x) * bf_hi(x_.x); dst[2] = bf_lo(g_.y) * bf_lo(x_.y); dst[3] = bf_hi(g_.y) * bf_hi(x_.y); \
                        dst[4] = bf_lo(g_.z) * bf_lo(x_.z); dst[5] = bf_hi(g_.z) * bf_hi(x_.z); dst[6] = bf_lo(g_.w) * bf_lo(x_.w); dst[7] = bf_hi(g_.w) * bf_hi(x_.w); } while (0)
                    MKU(up, gcr[0], xvr[0]); MKU(uc, gcr[1], xvr[1]);
#pragma unroll
                    for (int i = 0; i < 8; ++i) {
                        MKU(un, gcr[i + 2], xvr[i + 2]);
                        const u32x4 gb = gbr[i];
                        float gbf[8] = {bf_lo(gb.x), bf_hi(gb.x), bf_lo(gb.y), bf_hi(gb.y), bf_lo(gb.z), bf_hi(gb.z), bf_lo(gb.w), bf_hi(gb.w)};
                        float y[8];
#pragma unroll
                        for (int c = 0; c < 8; ++c) { y[c] = gbf[c] * (w0[c] * up[c] + w1[c] * uc[c] + w2[c] * un[c]); up[c] = uc[c]; uc[c] = un[c]; }
                        u32x4 o; o.x = cvt_pk_bf16(y[0], y[1]); o.y = cvt_pk_bf16(y[2], y[3]); o.z = cvt_pk_bf16(y[4], y[5]); o.w = cvt_pk_bf16(y[6], y[7]);
                        *(u32x4*)(MIXb + (size_t)(m0 + i) * DM + 512 + 8 * lane) = o;
                    }
#undef MKU
                }
            } else {
                const int lane = fresh_lane(); const int tid = wave0 * 64 + lane; (void)tid; (void)lane;
                const int xcd = bx & 7, li = bx >> 3;
                if (G == 256) {
                    { const int bh = 2 * xcd + (li >> 4); attn_unit2(lds, Qb, KNb, KPEb, VTb, MIXb, bh >> 3, bh & 7, (bh >> 3) * SEQ + (li & 15) * 512, 132, tid); }
                } else {
                    for (int uidx = bx; uidx < 512; uidx += G) { const int bh = uidx >> 5; attn_unit(lds, Qb, KNb, KPEb, VTb, MIXb, bh >> 3, bh & 7, (bh >> 3) * SEQ + (uidx & 31) * 256, 132, tid); }
                }
                if (l == 0) for (int uidx = bx; uidx < 16; uidx += G) attn_unit(lds, Qb, KNb, KPEb, VTb, MIXb, uidx >> 3, uidx & 7, ML + (uidx >> 3) * 256, 4, tid);
            }
        }
        { const bool ffn_in_seam = (ph >= 2 && ph < 18 && (((ph - 2) & 7) == 0 || ((ph - 2) & 7) == 6)) && (int)gridDim.x == 256;
          if (it + 1 < it_hi && !ffn_in_seam) grid.sync(); }
    }
    }
}

extern "C" void kernel_launch(void* const* d_in, const int* in_sizes, int n_in, void* d_out, int out_size, void* d_ws, size_t ws_size, hipStream_t stream) {
    static int grid_blocks = 0;
    if (grid_blocks == 0) {
        if (n_in != 19 || out_size != ML * DM || ws_size < WS_END) { fprintf(stderr, "kernel_launch: unexpected shapes (n_in %d out %d ws %zu need %zu)\n", n_in, out_size, ws_size, (size_t)WS_END); grid_blocks = -1; return; }
        int dev = 0, cus = 0, per_cu = 0;
        hipGetDevice(&dev);
        hipDeviceGetAttribute(&cus, hipDeviceAttributeMultiprocessorCount, dev);
        hipFuncSetAttribute((const void*)mega_fwd, hipFuncAttributeMaxDynamicSharedMemorySize, LDS_BYTES);
        hipOccupancyMaxActiveBlocksPerMultiprocessor(&per_cu, (const void*)mega_fwd, 512, LDS_BYTES);
        if (per_cu < 1) { fprintf(stderr, "kernel_launch: occupancy query says %d blocks/CU\n", per_cu); per_cu = 1; }
        if (per_cu > 1) per_cu = 1;
        grid_blocks = cus * per_cu;
    }
    if (grid_blocks < 0) return;
    hipMemsetAsync(d_ws, 0, ZERO_BYTES, stream);
    Args a{};
    for (int i = 0; i < 19; ++i) a.in[i] = (const float*)d_in[i];
    a.out = (float*)d_out; a.ws = (unsigned char*)d_ws;
#if MK_PER_PHASE_LAUNCH
    for (int ph = 0; ph < 19; ++ph) {
        a.ph_lo = ph; a.ph_hi = ph + 1;
        void* args[] = {&a};
        hipError_t e = hipLaunchCooperativeKernel((const void*)mega_fwd, dim3(grid_blocks), dim3(512), args, LDS_BYTES, stream);
        if (e != hipSuccess) { fprintf(stderr, "launch failed: %s\n", hipGetErrorString(e)); break; }
    }
#else
    a.ph_lo = 0; a.ph_hi = 19;
    void* args[] = {&a};
    hipError_t e = hipLaunchCooperativeKernel((const void*)mega_fwd, dim3(grid_blocks), dim3(512), args, LDS_BYTES, stream);
    if (e != hipSuccess) fprintf(stderr, "cooperative launch failed: %s (grid %d)\n", hipGetErrorString(e), grid_blocks);
#endif
}
```

```cpp
#include <hip/hip_runtime.h>
#include <hip/hip_cooperative_groups.h>
#include <cstdio>
#include <cstdint>
namespace cg = cooperative_groups;

#ifndef PROBE_DUP
#define PROBE_DUP (-1)
#endif
#ifndef MK_PER_PHASE_LAUNCH
#define MK_PER_PHASE_LAUNCH 0
#endif

#define LAS __attribute__((address_space(3)))
typedef unsigned short bf16_t;
typedef short bf16x8 __attribute__((ext_vector_type(8)));
typedef float f32x4 __attribute__((ext_vector_type(4)));
typedef float f32x2 __attribute__((ext_vector_type(2)));
typedef float f32x16 __attribute__((ext_vector_type(16)));
typedef unsigned u32x4 __attribute__((ext_vector_type(4)));
typedef unsigned u32x2 __attribute__((ext_vector_type(2)));

constexpr int DM = 1024, SEQ = 8192, ML = 16384, MC = 512, MT = 16896, DFF = 2816, NFF = 5632, DIN = 1952, DINP = 2048;
constexpr int NUP = 1280, KUP = 384, NMOD = 9216;
constexpr float EPS = 1e-6f;
constexpr float C2 = 0.10206207261596577f * 1.4426950408889634f;

constexpr size_t WS_MOD = 0;
constexpr size_t WS_CNT = 229376;
constexpr size_t WS_WUP = 262144;
constexpr size_t WUP_L = 1376256, WUP_VT = 983040;
constexpr size_t ZERO_BYTES = 262144 + 2 * WUP_L;
constexpr size_t WS_ROPE = ZERO_BYTES;
constexpr size_t WS_SW = WS_ROPE + 8192;
constexpr size_t SW_L = 39936;
constexpr size_t WS_SSQP = WS_SW + 2 * SW_L * 4;
constexpr size_t WS_SSQQ = WS_SSQP + (size_t)MT * 64;
constexpr size_t WS_SSQKV = WS_SSQQ + (size_t)MT * 16;
constexpr size_t WS_W = 5242880;
constexpr size_t W_1IN = 0, W_1OUT = 11534336, W_2IN = 17301504, W_2OUT = 28835840, W_IN = 34603008, W_OUT = 38797312, W_L = 40894464;
constexpr size_t WS_XCTX = WS_W + 2 * W_L;
constexpr size_t WS_XW = WS_XCTX + (size_t)MC * DM * 4;
constexpr size_t WS_H = WS_XW + (size_t)MT * DM * 2;
constexpr size_t WS_P = WS_H, WS_KN = WS_P + (size_t)MT * DINP * 2, WS_KPE = WS_KN + (size_t)MT * 512 * 2;
constexpr size_t WS_VT = WS_H + (size_t)MT * DFF * 2;
constexpr size_t WS_MIX = WS_VT + (size_t)512 * MT * 2;
constexpr size_t WS_END = WS_MIX + (size_t)MT * DM * 2;
static_assert(WS_SSQKV + (size_t)MT * 16 <= WS_W, "small region");
static_assert(WS_KPE + (size_t)MT * 64 <= WS_VT, "overlay");

constexpr int LDS_BYTES = 131072;

typedef __bf16 bf16x2_t __attribute__((ext_vector_type(2)));
__device__ __forceinline__ unsigned cvt_pk_bf16(float lo, float hi) { const f32x2 v = {lo, hi}; return __builtin_bit_cast(unsigned, __builtin_convertvector(v, bf16x2_t)); }
__device__ __forceinline__ float bf_lo(unsigned w) { return __builtin_bit_cast(float, w << 16); }
__device__ __forceinline__ float bf_hi(unsigned w) { return __builtin_bit_cast(float, w & 0xffff0000u); }
__device__ __forceinline__ float shx(float v, int o, int lane) { return __builtin_bit_cast(float, __builtin_amdgcn_ds_bpermute((lane ^ o) << 2, __builtin_bit_cast(int, v))); }
__device__ __forceinline__ float wave_sum(float v, int lane) {
#pragma unroll
    for (int o = 1; o < 64; o <<= 1) v += shx(v, o, lane);
    return v;
}
__device__ __forceinline__ float fast_silu(float g) { return g * __builtin_amdgcn_rcpf(1.0f + __builtin_amdgcn_exp2f(-1.4426950408889634f * g)); }
__device__ __forceinline__ float sum4(f32x4 v) { return (v.x + v.y) + (v.z + v.w); }
__device__ __forceinline__ float dot4(f32x4 v) { return (v.x * v.x + v.y * v.y) + (v.z * v.z + v.w * v.w); }
__device__ __forceinline__ float quad_sum(float t, int lane) { t += shx(t, 16, lane); t += shx(t, 32, lane); return t; }

__device__ __forceinline__ int fresh_lane() { int l; asm volatile("v_mbcnt_lo_u32_b32 %0, -1, 0\n\tv_mbcnt_hi_u32_b32 %0, -1, %0" : "=v"(l)); return l; }

namespace pg8 {
constexpr int BM = 256, BK = 64, HALF = 128, HTB = HALF * BK * 2, STAGE_BYTES = 8 * HTB, NXCD = 8, WGM = 8;
__host__ __device__ __forceinline__ int lds_byte(int r, int c) { const int st = (r >> 4) * 2 + (c >> 5), rr = r & 15, cc = c & 31, ob = rr * 64 + cc * 2; return st * 1024 + (ob ^ (((ob >> 9) & 1) << 5)); }
__host__ __device__ __forceinline__ void stage_rc(int b, int& R, int& C) { const int st = b / 1024, sb = b % 1024, swz = sb ^ (((sb >> 9) & 1) << 5); R = (st >> 1) * 16 + swz / 64; C = (st & 1) * 32 + (swz % 64) / 2; }
__host__ __device__ __forceinline__ int perm32(int rho) { const int n = rho >> 4, i = rho & 15; return 8 * (i >> 2) + 4 * n + (i & 3); }

struct Unit { int pm, pn; };
struct Gemm { const bf16_t* A; const bf16_t* Bt; int M, N, K, lda, ldb; };

struct StaticOrder {
    int nM, nN, nwg, G, c, wgm, xrow;
    __device__ __forceinline__ void init(int M, int N, int G_, int c_, int wgm_ = WGM, int xrow_ = 0) { nM = M / BM; nN = N / BM; nwg = nM * nN; G = G_; c = c_; wgm = wgm_; xrow = xrow_; }
    __device__ __forceinline__ bool next(int i, Unit& u) const {
        if (xrow) {
            const int x = c & 7, j = i * 32 + (c >> 3), nlat = 8 * nN;
            if (j < nlat) { const int grp = j / (4 * nN), w = j % (4 * nN); u.pm = 8 * x + 4 * grp + (w & 3); u.pn = w >> 2; return true; }
            const int ci = (j - nlat) * 8 + x;
            if (nM <= 64 || ci >= 2 * nN) return false;
            u.pm = 64 + ci / nN; u.pn = ci % nN; return true;
        }
        const long L = (long)i * G + c; if (L >= nwg) return false;
        int wgid = (int)L; { const int q = nwg / NXCD, r = nwg % NXCD, xcd = wgid % NXCD, off = wgid / NXCD; wgid = (xcd < r ? xcd * (q + 1) : r * (q + 1) + (xcd - r) * q) + off; }
        const int nig = wgm * nN, gid = wgid / nig, fm = gid * wgm, gsz = (nM - fm) < wgm ? (nM - fm) : wgm;
        u.pm = fm + ((wgid % nig) % gsz); u.pn = (wgid % nig) / gsz; return true;
    }
};

template <class Epi>
__device__ __forceinline__ void gemm_phase(LAS unsigned char* lds, const Gemm g, const StaticOrder& S, const Epi& E, const int tid_in) {
    int tid = tid_in; asm volatile("" : "+v"(tid));
    const int wid = __builtin_amdgcn_readfirstlane(tid >> 6), lane = tid & 63, wr = wid >> 2, wc = wid & 3, fr = lane & 15, fq = lane >> 4;
    const int K = g.K, nt = K / BK;
    unsigned voffA[2], voffB[2];
#pragma unroll
    for (int i = 0; i < 2; ++i) { int R, C; stage_rc(tid * 16 + i * 8192, R, C); const int Rb = Epi::PERM ? ((R & ~31) + perm32(R & 31)) : R;
        voffA[i] = (unsigned)(R * g.lda + C) * 2u; voffB[i] = (unsigned)(Rb * g.ldb + C) * 2u; }
    const size_t kstep = (size_t)(BK * 2);
    const size_t hstepA = (size_t)HALF * g.lda * 2, hstepB = (size_t)HALF * g.ldb * 2;
    const size_t tstepA = 2 * hstepA, tstepB = 2 * hstepB;
    const unsigned ldsw = (unsigned)wid * 1024u;
    const int aoff = lds_byte(wr * 64 + fr, fq * 8), boff = lds_byte(wc * 32 + fr, fq * 8);
#define PG8_SA(b, h) (((b) * 2 + (h)) * HTB)
#define PG8_SB(b, h) ((4 + (b) * 2 + (h)) * HTB)
#define PG8_STAGE(bufoff, gbase, voff) do { _Pragma("unroll") for (int _i = 0; _i < 2; ++_i) \
        __builtin_amdgcn_global_load_lds((const unsigned*)((const char*)(gbase) + (voff)[_i]), (LAS unsigned*)(lds + (bufoff) + ldsw + _i * 8192), 16, 0, 0); } while (0)
#define PG8_LDA(dst, b, h) do { _Pragma("unroll") for (int m = 0; m < 4; ++m) _Pragma("unroll") for (int k = 0; k < 2; ++k) dst[m][k] = *(const LAS bf16x8*)(lds + PG8_SA(b, h) + aoff + m * 2048 + k * 1024); } while (0)
#define PG8_LDB(dst, b, h) do { _Pragma("unroll") for (int n = 0; n < 2; ++n) _Pragma("unroll") for (int k = 0; k < 2; ++k) dst[n][k] = *(const LAS bf16x8*)(lds + PG8_SB(b, h) + boff + n * 2048 + k * 1024); } while (0)
#define PG8_MMA(ai, bj, At, Bt) do { __builtin_amdgcn_s_setprio(1); _Pragma("unroll") for (int m = 0; m < 4; ++m) _Pragma("unroll") for (int n = 0; n < 2; ++n) _Pragma("unroll") for (int k = 0; k < 2; ++k) \
        acc[ai][bj][m][n] = __builtin_amdgcn_mfma_f32_16x16x32_bf16(Bt[n][k], At[m][k], acc[ai][bj][m][n], 0, 0, 0); __builtin_amdgcn_s_setprio(0); } while (0)
#define PG8_WAIT_V(n) asm volatile("s_waitcnt vmcnt(" #n ")" ::: "memory")
#define PG8_WAIT_L(n) asm volatile("s_waitcnt lgkmcnt(" #n ")" ::: "memory")
#define PG8_BAR __builtin_amdgcn_s_barrier()
#define PG8_SCHED __builtin_amdgcn_sched_barrier(0)
    Unit cur, nxt; int ui = 0;
    if (!S.next(0, cur)) return;
    f32x4 acc[2][2][4][2];
#pragma unroll
    for (int a = 0; a < 2; ++a)
#pragma unroll
        for (int b = 0; b < 2; ++b)
#pragma unroll
            for (int m = 0; m < 4; ++m)
#pragma unroll
                for (int n = 0; n < 2; ++n) acc[a][b][m][n] = (f32x4){0.f, 0.f, 0.f, 0.f};
    bf16x8 At[4][2], B0[2][2], B1[2][2];
    const char* cA = (const char*)g.A + (size_t)cur.pm * tstepA; const char* cB = (const char*)g.Bt + (size_t)cur.pn * tstepB;
    PG8_STAGE(PG8_SB(0, 0), cB, voffB); PG8_STAGE(PG8_SB(0, 1), cB + hstepB, voffB); PG8_STAGE(PG8_SA(0, 0), cA, voffA); PG8_STAGE(PG8_SA(0, 1), cA + hstepA, voffA);
    if (wr == 1) PG8_BAR;
    PG8_WAIT_V(2); PG8_BAR;
    PG8_STAGE(PG8_SB(1, 0), cB + kstep, voffB); PG8_STAGE(PG8_SA(1, 0), cA + kstep, voffA); PG8_STAGE(PG8_SB(1, 1), cB + hstepB + kstep, voffB);
    PG8_WAIT_V(6); PG8_BAR;
    for (;;) {
        const bool has_next = S.next(ui + 1, nxt);
        const char* nA = has_next ? (const char*)g.A + (size_t)nxt.pm * tstepA : cA; const char* nB = has_next ? (const char*)g.Bt + (size_t)nxt.pn * tstepB : cB;
        for (int t = 0; t < nt; t += 2) {
            const bool last = (t == nt - 2);
            const char* a1 = cA + (size_t)(t + 1) * kstep;
            const char* a2 = last ? nA : cA + (size_t)(t + 2) * kstep; const char* b2 = last ? nB : cB + (size_t)(t + 2) * kstep;
            const char* a3 = a2 + kstep; const char* b3 = b2 + kstep;
            PG8_LDB(B0, 0, 0); PG8_LDB(B1, 0, 1); PG8_SCHED; PG8_LDA(At, 0, 0); PG8_STAGE(PG8_SA(1, 1), a1 + hstepA, voffA);
            PG8_WAIT_V(8); PG8_WAIT_L(0); PG8_BAR; PG8_MMA(0, 0, At, B0); PG8_MMA(0, 1, At, B1); PG8_BAR; PG8_SCHED;
            PG8_LDA(At, 0, 1); PG8_STAGE(PG8_SB(0, 0), b2, voffB); PG8_STAGE(PG8_SB(0, 1), b2 + hstepB, voffB); PG8_STAGE(PG8_SA(0, 0), a2, voffA);
            PG8_WAIT_V(8); PG8_WAIT_L(0); PG8_BAR; PG8_MMA(1, 0, At, B0); PG8_MMA(1, 1, At, B1); PG8_BAR; PG8_SCHED;
            PG8_LDB(B0, 1, 0); PG8_LDB(B1, 1, 1); PG8_SCHED; PG8_LDA(At, 1, 0); PG8_STAGE(PG8_SA(0, 1), a2 + hstepA, voffA);
            PG8_WAIT_V(8); PG8_WAIT_L(0); PG8_BAR; PG8_MMA(0, 0, At, B0); PG8_MMA(0, 1, At, B1); PG8_BAR; PG8_SCHED;
            PG8_LDA(At, 1, 1); PG8_STAGE(PG8_SB(1, 0), b3, voffB); PG8_STAGE(PG8_SB(1, 1), b3 + hstepB, voffB); PG8_STAGE(PG8_SA(1, 0), a3, voffA);
            PG8_WAIT_V(8); PG8_WAIT_L(0); PG8_BAR; PG8_MMA(1, 0, At, B0); PG8_MMA(1, 1, At, B1); PG8_BAR; PG8_SCHED;
        }
        if (wr == 0) PG8_BAR;
        E(acc, cur, wr, wc, fr, fq);
        if (!has_next) break;
#pragma unroll
        for (int a = 0; a < 2; ++a)
#pragma unroll
            for (int b = 0; b < 2; ++b)
#pragma unroll
                for (int m = 0; m < 4; ++m)
#pragma unroll
                    for (int n = 0; n < 2; ++n) acc[a][b][m][n] = (f32x4){0.f, 0.f, 0.f, 0.f};
        cur = nxt; cA = nA; cB = nB; ++ui;
        if (wr == 1) PG8_BAR;
    }
    PG8_WAIT_V(0);
    PG8_BAR;
#undef PG8_SA
#undef PG8_SB
#undef PG8_STAGE
#undef PG8_LDA
#undef PG8_LDB
#undef PG8_MMA
#undef PG8_WAIT_V
#undef PG8_WAIT_L
#undef PG8_BAR
#undef PG8_SCHED
}

__device__ __forceinline__ int stream_of(int pm) { return pm < 32 ? 0 : (pm < 64 ? 1 : 2); }

__device__ __forceinline__ void rope_apply(f32x4& a, f32x4& b, const float* rope, int row, int fq) {
    const int pos = (fq >> 1) ? (row & 63) : ((row >> 6) & 127);
    const float* tp = rope + (pos * 8 + 4 * (fq & 1)) * 2;
    const f32x4 cs0 = *(const f32x4*)tp, cs1 = *(const f32x4*)(tp + 4);
    const f32x4 c = (f32x4){cs0.x, cs0.z, cs1.x, cs1.z}, s = (f32x4){cs0.y, cs0.w, cs1.y, cs1.w};
    const f32x4 o1 = a * c - b * s, o2 = b * c + a * s; a = o1; b = o2;
}

struct EpiSwiglu {
    static constexpr bool PERM = true;
    bf16_t* H; const float* ssqp; const float* sW; unsigned* cnt;
    __device__ __forceinline__ void operator()(const f32x4 (&acc)[2][2][4][2], const Unit& u, int wr, int wc, int fr, int fq) const { run<0, 2>(acc, u, wr, wc, fr, fq); }
    template <int A0, int A1> __device__ __forceinline__ void run(const f32x4 (&acc)[2][2][4][2], const Unit& u, int wr, int wc, int fr, int fq) const {
        const int s = stream_of(u.pm);
        const int cb = u.pn * 256 + wc * 32 + fq * 8;
        const float* bp = sW + s * NFF + cb;
        f32x4 bg[2], bu[2];
#pragma unroll
        for (int n = 0; n < 2; ++n) { bg[n] = *(const f32x4*)(bp + 4 * n); bu[n] = *(const f32x4*)(bp + 128 + 4 * n); }
        const int row0 = u.pm * 256 + wr * 64 + fr;
#pragma unroll
        for (int ai = A0; ai < A1; ++ai)
#pragma unroll
            for (int m = 0; m < 4; ++m) {
                const int row = row0 + ai * 128 + m * 16;
                const float t = quad_sum(sum4(*(const f32x4*)(ssqp + (size_t)row * 16 + 4 * fq)), fq * 16 + fr);
                const float rr = rsqrtf(t * (1.0f / 1024.0f) + EPS);
                u32x4 w;
#pragma unroll
                for (int n = 0; n < 2; ++n) {
                    const f32x4 gg = acc[ai][0][m][n] * rr + bg[n], uu = acc[ai][1][m][n] * rr + bu[n];
                    const float h0 = fast_silu(gg.x) * uu.x, h1 = fast_silu(gg.y) * uu.y, h2 = fast_silu(gg.z) * uu.z, h3 = fast_silu(gg.w) * uu.w;
                    w[2 * n] = cvt_pk_bf16(h0, h1); w[2 * n + 1] = cvt_pk_bf16(h2, h3);
                }
                bf16_t* hp = H + (size_t)row * DFF + u.pn * 128 + wc * 32 + fq * 8;
                if (cnt) asm volatile("global_store_dwordx4 %0, %1, off sc0 sc1" :: "v"(hp), "v"(w) : "memory");
                else *(u32x4*)hp = w;
            }
        if (cnt && A1 - A0 == 2) {
            asm volatile("s_waitcnt vmcnt(0)" ::: "memory");
            if (fr == 0 && fq == 0) __hip_atomic_fetch_add(cnt + u.pm, 1u, __ATOMIC_RELAXED, __HIP_MEMORY_SCOPE_AGENT);
        }
    }
};

struct EpiResid {
    static constexpr bool PERM = true;
    const float* xo_lat; const float* xo_ctx; float* xn_lat; float* xn_ctx;
    const float* gate; const float* nw; const float* nscale; bf16_t* Xw; float* ssqp; int full_gate; int has_next;
    __device__ __forceinline__ void operator()(const f32x4 (&acc)[2][2][4][2], const Unit& u, int wr, int wc, int fr, int fq) const { run<0, 2>(acc, u, wr, wc, fr, fq); }
    template <int A0, int A1> __device__ __forceinline__ void run(const f32x4 (&acc)[2][2][4][2], const Unit& u, int wr, int wc, int fr, int fq) const {
        const int s = stream_of(u.pm);
        const float gmul = full_gate ? 1.0f : 0.5f;
        const float* xo = (u.pm < 64) ? xo_lat : xo_ctx - (size_t)ML * DM;
        float* xn = (u.pm < 64) ? xn_lat : xn_ctx - (size_t)ML * DM;
        const int row0 = u.pm * 256 + wr * 64 + fr;
        float ssq[2][4];
#pragma unroll
        for (int ai = A0; ai < A1; ++ai)
#pragma unroll
            for (int m = 0; m < 4; ++m) ssq[ai][m] = 0.f;
#pragma unroll
        for (int bj = 0; bj < 2; ++bj) {
            const int col = u.pn * 256 + bj * 128 + wc * 32 + fq * 8;
            const f32x4 gv0 = *(const f32x4*)(gate + s * NMOD + col) * gmul, gv1 = *(const f32x4*)(gate + s * NMOD + col + 4) * gmul;
            f32x4 wv0 = (f32x4){0.f, 0.f, 0.f, 0.f}, wv1 = wv0;
            if (has_next) { wv0 = *(const f32x4*)(nw + col) * (*(const f32x4*)(nscale + s * NMOD + col) + 1.0f); wv1 = *(const f32x4*)(nw + col + 4) * (*(const f32x4*)(nscale + s * NMOD + col + 4) + 1.0f); }
#pragma unroll
            for (int ai = A0; ai < A1; ++ai)
#pragma unroll
                for (int m = 0; m < 4; ++m) {
                    const size_t off = (size_t)(row0 + ai * 128 + m * 16) * DM + col;
                    const f32x4 x0 = *(const f32x4*)(xo + off) + gv0 * acc[ai][bj][m][0];
                    const f32x4 x1 = *(const f32x4*)(xo + off + 4) + gv1 * acc[ai][bj][m][1];
                    *(f32x4*)(xn + off) = x0; *(f32x4*)(xn + off + 4) = x1;
                    ssq[ai][m] += dot4(x0) + dot4(x1);
                    if (has_next) { const f32x4 y0 = x0 * wv0, y1 = x1 * wv1; u32x4 w; w.x = cvt_pk_bf16(y0.x, y0.y); w.y = cvt_pk_bf16(y0.z, y0.w); w.z = cvt_pk_bf16(y1.x, y1.y); w.w = cvt_pk_bf16(y1.z, y1.w); *(u32x4*)(Xw + off) = w; }
                }
        }
#pragma unroll
        for (int ai = A0; ai < A1; ++ai)
#pragma unroll
            for (int m = 0; m < 4; ++m) {
                const float t = quad_sum(ssq[ai][m], fq * 16 + fr);
                if (fq == 0) ssqp[(size_t)(row0 + ai * 128 + m * 16) * 16 + u.pn * 4 + wc] = t;
            }
    }
};

struct EpiInproj {
    static constexpr bool PERM = true;
    bf16_t* P; bf16_t* KPE; const float* ssqp; const float* sW; float* ssqq; float* ssqkv; const float* rope;
    __device__ __forceinline__ void operator()(const f32x4 (&acc)[2][2][4][2], const Unit& u, int wr, int wc, int fr, int fq) const { run<0, 2>(acc, u, wr, wc, fr, fq); }
    template <int A0, int A1> __device__ __forceinline__ void run(const f32x4 (&acc)[2][2][4][2], const Unit& u, int wr, int wc, int fr, int fq) const {
        const int s = stream_of(u.pm);
        const int cb = u.pn * 256 + wc * 32 + fq * 8;
        f32x4 b[2][2];
#pragma unroll
        for (int bj = 0; bj < 2; ++bj)
#pragma unroll
            for (int n = 0; n < 2; ++n) b[bj][n] = *(const f32x4*)(sW + s * DINP + cb + bj * 128 + 4 * n);
        const int row0 = u.pm * 256 + wr * 64 + fr;
#pragma unroll
        for (int ai = A0; ai < A1; ++ai)
#pragma unroll
            for (int m = 0; m < 4; ++m) {
                const int row = row0 + ai * 128 + m * 16;
                const float t = quad_sum(sum4(*(const f32x4*)(ssqp + (size_t)row * 16 + 4 * fq)), fq * 16 + fr);
                const float rr = rsqrtf(t * (1.0f / 1024.0f) + EPS);
                f32x4 v[2][2];
#pragma unroll
                for (int bj = 0; bj < 2; ++bj)
#pragma unroll
                    for (int n = 0; n < 2; ++n) v[bj][n] = acc[ai][bj][m][n] * rr + b[bj][n];
                if (u.pn == 0) {
                    const float q = quad_sum((dot4(v[0][0]) + dot4(v[0][1])) + (dot4(v[1][0]) + dot4(v[1][1])), fq * 16 + fr);
                    if (fq == 0) ssqq[(size_t)row * 4 + wc] = q;
                } else if (u.pn == 1) {
                    const float q = quad_sum(dot4(v[0][0]) + dot4(v[0][1]), fq * 16 + fr);
                    if (fq == 0) ssqkv[(size_t)row * 4 + wc] = q;
                }
#pragma unroll
                for (int bj = 0; bj < 2; ++bj) {
                    u32x4 w; w.x = cvt_pk_bf16(v[bj][0].x, v[bj][0].y); w.y = cvt_pk_bf16(v[bj][0].z, v[bj][0].w); w.z = cvt_pk_bf16(v[bj][1].x, v[bj][1].y); w.w = cvt_pk_bf16(v[bj][1].z, v[bj][1].w);
                    *(u32x4*)(P + (size_t)row * DINP + cb + bj * 128) = w;
                }
                if (u.pn == 1 && wc == 0) {
                    f32x4 a = v[1][0], bb = v[1][1];
                    if (u.pm < 64) rope_apply(a, bb, rope, row, fq);
                    u32x4 w; w.x = cvt_pk_bf16(a.x, a.y); w.y = cvt_pk_bf16(a.z, a.w); w.z = cvt_pk_bf16(bb.x, bb.y); w.w = cvt_pk_bf16(bb.z, bb.w);
                    *(u32x4*)(KPE + (size_t)row * 32 + fq * 8) = w;
                }
            }
    }
};

struct EpiUpQK {
    static constexpr bool PERM = true;
    bf16_t* Q; bf16_t* KN; const float* ssqq; const float* ssqkv; const float* rope; int pn_off;
    __device__ __forceinline__ void operator()(const f32x4 (&acc)[2][2][4][2], const Unit& u, int wr, int wc, int fr, int fq) const { run<0, 2>(acc, u, wr, wc, fr, fq); }
    template <int A0, int A1> __device__ __forceinline__ void run(const f32x4 (&acc)[2][2][4][2], const Unit& u, int wr, int wc, int fr, int fq) const {
        const int lpn = u.pn + pn_off;
        const bool isq = lpn < 3;
        const int row0 = u.pm * 256 + wr * 64 + fr;
#pragma unroll
        for (int ai = A0; ai < A1; ++ai)
#pragma unroll
            for (int m = 0; m < 4; ++m) {
                const int row = row0 + ai * 128 + m * 16;
                const f32x4 pv = isq ? *(const f32x4*)(ssqq + (size_t)row * 4) : *(const f32x4*)(ssqkv + (size_t)row * 4);
                const float rr = isq ? rsqrtf(sum4(pv) * (1.0f / 256.0f) + EPS) * C2 : rsqrtf(sum4(pv) * (1.0f / 128.0f) + EPS);
#pragma unroll
                for (int bj = 0; bj < 2; ++bj) {
                    const int cbase = lpn * 256 + bj * 128 + wc * 32;
                    f32x4 v0 = acc[ai][bj][m][0] * rr, v1 = acc[ai][bj][m][1] * rr;
                    if (isq && ((cbase >> 5) % 3) == 2 && u.pm < 64) rope_apply(v0, v1, rope, row, fq);
                    u32x4 w; w.x = cvt_pk_bf16(v0.x, v0.y); w.y = cvt_pk_bf16(v0.z, v0.w); w.z = cvt_pk_bf16(v1.x, v1.y); w.w = cvt_pk_bf16(v1.z, v1.w);
                    if (isq) *(u32x4*)(Q + (size_t)row * 768 + cbase + fq * 8) = w;
                    else *(u32x4*)(KN + (size_t)row * 512 + (cbase - 768) + fq * 8) = w;
                }
            }
    }
};

struct EpiVT {
    static constexpr bool PERM = true;
    bf16_t* VT; const float* ssqkv;
    __device__ __forceinline__ void operator()(const f32x4 (&acc)[2][2][4][2], const Unit& u, int wr, int wc, int fr, int fq) const { run<0, 2>(acc, u, wr, wc, fr, fq); }
    template <int A0, int A1> __device__ __forceinline__ void run(const f32x4 (&acc)[2][2][4][2], const Unit& u, int wr, int wc, int fr, int fq) const {
        f32x4 rr[2][2];
#pragma unroll
        for (int bj = 0; bj < 2; ++bj)
#pragma unroll
            for (int n = 0; n < 2; ++n) {
                const int tok0 = u.pn * 256 + bj * 128 + wc * 32 + fq * 8 + n * 4;
#pragma unroll
                for (int j = 0; j < 4; ++j) rr[bj][n][j] = rsqrtf(sum4(*(const f32x4*)(ssqkv + (size_t)(tok0 + j) * 4)) * (1.0f / 128.0f) + EPS);
            }
        const int drow0 = u.pm * 256 + wr * 64 + fr;
#pragma unroll
        for (int ai = A0; ai < A1; ++ai)
#pragma unroll
            for (int m = 0; m < 4; ++m) {
                const int drow = drow0 + ai * 128 + m * 16;
#pragma unroll
                for (int bj = 0; bj < 2; ++bj) {
                    const f32x4 v0 = acc[ai][bj][m][0] * rr[bj][0], v1 = acc[ai][bj][m][1] * rr[bj][1];
                    u32x4 w; w.x = cvt_pk_bf16(v0.x, v0.y); w.y = cvt_pk_bf16(v0.z, v0.w); w.z = cvt_pk_bf16(v1.x, v1.y); w.w = cvt_pk_bf16(v1.z, v1.w);
                    *(u32x4*)(VT + (size_t)drow * MT + u.pn * 256 + bj * 128 + wc * 32 + fq * 8) = w;
                }
            }
    }
};

template <class Epi, int AI>
__device__ __forceinline__ void skinny_item(LAS unsigned char* lds, const Gemm g, const Epi& E, const Unit u, int wr, int wc, int wave, int lane) {
    const int fr = lane & 15, fq = lane >> 4;
    f32x4 acc[2][2][4][2];
#pragma unroll
    for (int b = 0; b < 2; ++b)
#pragma unroll
        for (int m = 0; m < 4; ++m)
#pragma unroll
            for (int n = 0; n < 2; ++n) acc[AI][b][m][n] = (f32x4){0.f, 0.f, 0.f, 0.f};
    const bf16_t* pa = g.A + (size_t)(u.pm * 256 + AI * 128 + wr * 64 + fr) * g.lda + fq * 8;
    const bf16_t* pb0 = g.Bt + (size_t)(u.pn * 256 + wc * 32 + (Epi::PERM ? perm32(fr) : fr)) * g.ldb + fq * 8;
    const bf16_t* pb1 = g.Bt + (size_t)(u.pn * 256 + wc * 32 + (Epi::PERM ? perm32(16 + fr) : 16 + fr)) * g.ldb + fq * 8;
    const size_t as = (size_t)16 * g.lda, bs = (size_t)128 * g.ldb;
    const int nch = g.K >> 7, kbeg = ((wave * nch) >> 3) << 7, kend = (((wave + 1) * nch) >> 3) << 7;
    bf16x8 a0[2][4], b0[2][2][2], a1[2][4], b1[2][2][2];
#define SK_LOAD(A_, B_, kb) do { _Pragma("unroll") for (int kk = 0; kk < 2; ++kk) { \
        _Pragma("unroll") for (int m = 0; m < 4; ++m) A_[kk][m] = *(const bf16x8*)(pa + m * as + (kb) + 32 * kk); \
        _Pragma("unroll") for (int bj = 0; bj < 2; ++bj) { B_[kk][bj][0] = *(const bf16x8*)(pb0 + bj * bs + (kb) + 32 * kk); B_[kk][bj][1] = *(const bf16x8*)(pb1 + bj * bs + (kb) + 32 * kk); } } } while (0)
#define SK_MMA(A_, B_) do { _Pragma("unroll") for (int kk = 0; kk < 2; ++kk) _Pragma("unroll") for (int bj = 0; bj < 2; ++bj) _Pragma("unroll") for (int m = 0; m < 4; ++m) _Pragma("unroll") for (int n = 0; n < 2; ++n) \
        acc[AI][bj][m][n] = __builtin_amdgcn_mfma_f32_16x16x32_bf16(B_[kk][bj][n], A_[kk][m], acc[AI][bj][m][n], 0, 0, 0); } while (0)
#pragma unroll 1
    for (int k = kbeg; k < kend; k += 128) {
        SK_LOAD(a0, b0, k);
        SK_LOAD(a1, b1, k + 64);
        SK_MMA(a0, b0);
        SK_MMA(a1, b1);
    }
#undef SK_LOAD
#undef SK_MMA
    if (wave > 0) {
#pragma unroll
        for (int bj = 0; bj < 2; ++bj)
#pragma unroll
            for (int m = 0; m < 4; ++m)
#pragma unroll
                for (int n = 0; n < 2; ++n) *(LAS f32x4*)(lds + (((wave - 1) * 16 + bj * 8 + m * 2 + n) * 64 + lane) * 16) = acc[AI][bj][m][n];
    }
    __syncthreads();
    if (wave == 0) {
#pragma unroll 1
        for (int w = 0; w < 7; ++w) {
#pragma unroll
            for (int bj = 0; bj < 2; ++bj)
#pragma unroll
                for (int m = 0; m < 4; ++m)
#pragma unroll
                    for (int n = 0; n < 2; ++n) acc[AI][bj][m][n] += *(const LAS f32x4*)(lds + ((w * 16 + bj * 8 + m * 2 + n) * 64 + lane) * 16);
        }
        E.template run<AI, AI + 1>(acc, u, wr, wc, fr, fq);
    }
    __syncthreads();
}
template <class Epi>
__device__ __forceinline__ void skinny_ctx(LAS unsigned char* lds, const Gemm g, const Epi& E, int nN, int first, int stride, int wave, int lane, int pn_base = 0) {
    const int nitems = 2 * nN * 16;
    for (int it = first; it < nitems; it += stride) {
        const int un = it >> 4, sub = it & 15;
        Unit u; u.pm = 64 + (un & 1); u.pn = pn_base + (un >> 1);
        const int wr = (sub >> 2) & 1, wc = sub & 3;
        if (sub & 8) skinny_item<Epi, 1>(lds, g, E, u, wr, wc, wave, lane); else skinny_item<Epi, 0>(lds, g, E, u, wr, wc, wave, lane);
    }
}
}

constexpr int KROW = 208, VROW = 144, KBUF = 64 * KROW, VBUF = 64 * VROW;
__device__ __forceinline__ float max2f(float a, float b) { return __builtin_fmaxf(a, b); }
__device__ __forceinline__ float max3f(float a, float b, float c) { float r; asm("v_max3_f32 %0, %1, %2, %3" : "=v"(r) : "v"(a), "v"(b), "v"(c)); return r; }
__device__ __forceinline__ float xhalf_max(float m) { auto rr = __builtin_amdgcn_permlane32_swap(__float_as_uint(m), __float_as_uint(m), false, false); return max2f(__uint_as_float(rr[0]), __uint_as_float(rr[1])); }
__device__ __forceinline__ float xhalf_sum(float m) { auto rr = __builtin_amdgcn_permlane32_swap(__float_as_uint(m), __float_as_uint(m), false, false); return __uint_as_float(rr[0]) + __uint_as_float(rr[1]); }

__device__ __forceinline__ void attn_unit(LAS unsigned char* lds, const bf16_t* __restrict__ Q, const bf16_t* __restrict__ KN, const bf16_t* __restrict__ KPE,
                                          const bf16_t* __restrict__ VT, bf16_t* __restrict__ MIX, int b, int h, int qrow0, int ntiles, const int tid_in) {
    int tid = tid_in; asm volatile("" : "+v"(tid));
    const int lane = tid & 63, r32 = lane & 31, hi = lane >> 5, wid = __builtin_amdgcn_readfirstlane(tid >> 6);
    const bf16_t* qp = Q + (size_t)(qrow0 + wid * 32 + r32) * 768 + h * 96 + hi * 8;
    bf16x8 qf[6];
#pragma unroll
    for (int ds = 0; ds < 6; ++ds) qf[ds] = *(const bf16x8*)(qp + ds * 16);
    const int kkey = tid >> 3, kc = tid & 7, pkey = (tid >> 2) & 63, pc = tid & 3;
    const bf16_t* knp = KN + (size_t)kkey * 512 + h * 64 + kc * 8;
    const bf16_t* kpp = KPE + (size_t)pkey * 32 + pc * 8;
    const bf16_t* vtp = VT + (size_t)(h * 64 + kkey) * MT + kc * 8;
    const int kw_off = kkey * KROW + kc * 16, pw_off = pkey * KROW + 128 + pc * 16, vw_off = KBUF + kkey * VROW + kc * 16;
    const int pi = (r32 & 0x13) | ((r32 & 4) << 1) | ((r32 & 8) >> 1);
    const int ka_off = pi * KROW + hi * 16, va_off = KBUF + r32 * VROW + hi * 16;
    constexpr int SLOT = KBUF + VBUF;
    u32x4 gk, gp, gv;
    gp = (u32x4){0u, 0u, 0u, 0u};
    bf16x8 kf[12], vf[8];
#define ROWBASE(kt) ((kt) < 4 ? (ML + 256 * b + 64 * (kt)) : (SEQ * b + 64 * ((kt) - 4)))
#define LOADT(kt) do { const int rb_ = ROWBASE(kt); gk = *(const u32x4*)(knp + (size_t)rb_ * 512); if (tid < 256) gp = *(const u32x4*)(kpp + (size_t)rb_ * 32); gv = *(const u32x4*)(vtp + rb_); } while (0)
#define STORET(so) do { *(LAS u32x4*)(lds + (so) + kw_off) = gk; if (tid < 256) *(LAS u32x4*)(lds + (so) + pw_off) = gp; *(LAS u32x4*)(lds + (so) + vw_off) = gv; } while (0)
#define LDK(so) do { _Pragma("unroll") for (int ds = 0; ds < 6; ++ds) { kf[2 * ds] = *(const LAS bf16x8*)(lds + (so) + ka_off + ds * 32); kf[2 * ds + 1] = *(const LAS bf16x8*)(lds + (so) + ka_off + 32 * KROW + ds * 32); } } while (0)
#define LDV(so) do { _Pragma("unroll") for (int st = 0; st < 4; ++st) { vf[2 * st] = *(const LAS bf16x8*)(lds + (so) + va_off + st * 32); vf[2 * st + 1] = *(const LAS bf16x8*)(lds + (so) + va_off + 32 * VROW + st * 32); } } while (0)
    LOADT(0); STORET(0);
    LOADT(1); STORET(SLOT);
    __syncthreads();
    LDK(0);
    int sc = 0, sn = SLOT, snn = 2 * SLOT;
    f32x16 o0 = {}, o1 = {}, o2 = {}, negm = {};
    float mref = 0.f;
    const short one_b = (r32 == 0) ? (short)0x3f80 : (short)0;
    const bf16x8 ones = (bf16x8){one_b, one_b, one_b, one_b, one_b, one_b, one_b, one_b};
    for (int t = 0; t < ntiles; ++t) {
        if (t + 2 < ntiles) LOADT(t + 2);
        LDV(sc);
        __builtin_amdgcn_sched_barrier(0);
        f32x16 s0 = negm, s1 = negm;
#pragma unroll
        for (int ds = 0; ds < 6; ++ds) {
            s0 = __builtin_amdgcn_mfma_f32_32x32x16_bf16(kf[2 * ds], qf[ds], s0, 0, 0, 0);
            s1 = __builtin_amdgcn_mfma_f32_32x32x16_bf16(kf[2 * ds + 1], qf[ds], s1, 0, 0, 0);
        }
        __builtin_amdgcn_sched_barrier(0);
        float m4[4];
#pragma unroll
        for (int c = 0; c < 4; ++c) m4[c] = max2f(s0[c], s1[c]);
#pragma unroll
        for (int r = 4; r < 16; ++r) m4[r & 3] = max2f(max2f(m4[r & 3], s0[r]), s1[r]);
        float mx = max2f(max2f(m4[0], m4[1]), max2f(m4[2], m4[3]));
        mx = xhalf_max(mx);
        if (t == 0 || __any(mx > 8.0f)) {
            const float d = (t == 0) ? mx : max2f(mx, 0.f);
            mref += d;
#pragma unroll
            for (int r = 0; r < 16; ++r) { s0[r] -= d; s1[r] -= d; negm[r] = -mref; }
            const float f = (t == 0) ? 1.0f : __builtin_amdgcn_exp2f(-d);
            o2[0] *= f;
#pragma unroll
            for (int r = 0; r < 16; ++r) { o0[r] *= f; o1[r] *= f; }
        }
#pragma unroll
        for (int r = 0; r < 16; ++r) { s0[r] = __builtin_amdgcn_exp2f(s0[r]); s1[r] = __builtin_amdgcn_exp2f(s1[r]); }
        u32x4 pw[4];
#pragma unroll
        for (int j = 0; j < 4; ++j) { pw[0][j] = cvt_pk_bf16(s0[2 * j], s0[2 * j + 1]); pw[1][j] = cvt_pk_bf16(s0[8 + 2 * j], s0[8 + 2 * j + 1]);
                                      pw[2][j] = cvt_pk_bf16(s1[2 * j], s1[2 * j + 1]); pw[3][j] = cvt_pk_bf16(s1[8 + 2 * j], s1[8 + 2 * j + 1]); }
        __builtin_amdgcn_sched_barrier(0);
        if (t + 1 < ntiles) LDK(sn);
#pragma unroll
        for (int st = 0; st < 4; ++st) {
            const bf16x8 pf = __builtin_bit_cast(bf16x8, pw[st]);
            o0 = __builtin_amdgcn_mfma_f32_32x32x16_bf16(vf[2 * st], pf, o0, 0, 0, 0);
            o1 = __builtin_amdgcn_mfma_f32_32x32x16_bf16(vf[2 * st + 1], pf, o1, 0, 0, 0);
            o2 = __builtin_amdgcn_mfma_f32_32x32x16_bf16(ones, pf, o2, 0, 0, 0);
        }
        __builtin_amdgcn_sched_barrier(0);
        if (t + 2 < ntiles) STORET(snn);
        __syncthreads();
        { const int tmp = sc; sc = sn; sn = snn; snn = tmp; }
    }
#undef ROWBASE
#undef LOADT
#undef STORET
#undef LDK
#undef LDV
    const float inv = __builtin_amdgcn_rcpf(xhalf_sum(hi == 0 ? o2[0] : 0.f));
    bf16_t* op = MIX + (size_t)(qrow0 + wid * 32 + r32) * DM + h * 64 + 4 * hi;
#pragma unroll
    for (int g = 0; g < 4; ++g) {
        u32x2 w0, w1;
        w0.x = cvt_pk_bf16(o0[4 * g] * inv, o0[4 * g + 1] * inv); w0.y = cvt_pk_bf16(o0[4 * g + 2] * inv, o0[4 * g + 3] * inv);
        w1.x = cvt_pk_bf16(o1[4 * g] * inv, o1[4 * g + 1] * inv); w1.y = cvt_pk_bf16(o1[4 * g + 2] * inv, o1[4 * g + 3] * inv);
        *(u32x2*)(op + 8 * g) = w0; *(u32x2*)(op + 32 + 8 * g) = w1;
    }
}

__device__ __forceinline__ void attn_unit2(LAS unsigned char* lds, const bf16_t* __restrict__ Q, const bf16_t* __restrict__ KN, const bf16_t* __restrict__ KPE,
                                           const bf16_t* __restrict__ VT, bf16_t* __restrict__ MIX, int b, int h, int qrow0, int ntiles, const int tid_in) {
    int tid = tid_in; asm volatile("" : "+v"(tid));
    const int lane = tid & 63, r32 = lane & 31, hi = lane >> 5, wid = __builtin_amdgcn_readfirstlane(tid >> 6);
    const bf16_t* qp = Q + (size_t)(qrow0 + wid * 64 + r32) * 768 + h * 96 + hi * 8;
    bf16x8 qa[6], qb[6];
#pragma unroll
    for (int ds = 0; ds < 6; ++ds) { qa[ds] = *(const bf16x8*)(qp + ds * 16); qb[ds] = *(const bf16x8*)(qp + (size_t)32 * 768 + ds * 16); }
    const int pi = (r32 & 0x13) | ((r32 & 4) << 1) | ((r32 & 8) >> 1);
    const int ka_off = pi * KROW + hi * 16, va_off = KBUF + r32 * VROW + hi * 16;
    constexpr int SLOT = KBUF + VBUF;
    const char* dsrc[3]; unsigned dmul[3]; int dlds[3];
#pragma unroll
    for (int r = 0; r < 3; ++r) {
        const int ii = wid + 8 * r;
        if (ii < 13) {
            const int p = 64 * ii + lane, row = p / 13, cc = p % 13;
            if (cc >= 8 && cc < 12) { dsrc[r] = (const char*)(KPE + (size_t)row * 32 + 8 * (cc - 8)); dmul[r] = 64u; }
            else { dsrc[r] = (const char*)(KN + (size_t)row * 512 + h * 64 + 8 * (cc == 12 ? 0 : cc)); dmul[r] = 1024u; }
            dlds[r] = 1024 * ii;
        } else {
            const int p = 64 * (ii - 13) + lane, d = p / 9, cc = p % 9;
            dsrc[r] = (const char*)(VT + (size_t)(h * 64 + (d < 64 ? d : 63)) * MT + 8 * (cc == 8 ? 0 : cc)); dmul[r] = 2u;
            dlds[r] = KBUF + 1024 * (ii - 13);
        }
    }
#define ROWBASE(kt) ((kt) < 4 ? (ML + 256 * b + 64 * (kt)) : (SEQ * b + 64 * ((kt) - 4)))
#define DMAT(kt, so) do { const unsigned rb_ = (unsigned)ROWBASE(kt); _Pragma("unroll") for (int r = 0; r < 3; ++r) if (wid + 8 * r < 22) \
        __builtin_amdgcn_global_load_lds((const unsigned*)(dsrc[r] + (size_t)rb_ * dmul[r]), (LAS unsigned*)(lds + (so) + dlds[r]), 16, 0, 0); } while (0)
    DMAT(0, 0);
    DMAT(1, SLOT);
    __syncthreads();
    int sc = 0, sn = SLOT, snn = 2 * SLOT;
    f32x16 oa0 = {}, oa1 = {}, ob0 = {}, ob1 = {};
    float ma = -1.0e30f, mb = -1.0e30f, la = 0.f, lb = 0.f;
    for (int t = 0; t < ntiles; ++t) {
        __builtin_amdgcn_sched_barrier(0);
        f32x16 sa0 = {}, sa1 = {}, sb0 = {}, sb1 = {};
        const LAS unsigned char* ka = lds + sc + ka_off;
#pragma unroll
        for (int ds = 0; ds < 6; ++ds) {
            const bf16x8 k0 = *(const LAS bf16x8*)(ka + ds * 32);
            const bf16x8 k1 = *(const LAS bf16x8*)(ka + 32 * KROW + ds * 32);
            sa0 = __builtin_amdgcn_mfma_f32_32x32x16_bf16(k0, qa[ds], sa0, 0, 0, 0);
            sa1 = __builtin_amdgcn_mfma_f32_32x32x16_bf16(k1, qa[ds], sa1, 0, 0, 0);
            sb0 = __builtin_amdgcn_mfma_f32_32x32x16_bf16(k0, qb[ds], sb0, 0, 0, 0);
            sb1 = __builtin_amdgcn_mfma_f32_32x32x16_bf16(k1, qb[ds], sb1, 0, 0, 0);
        }
        __builtin_amdgcn_sched_barrier(0);
        if (t + 2 < ntiles) DMAT(t + 2, snn);
        u32x4 pa[4], pb[4];
#define SOFTMAX2(S0, S1, MREF, LSUM, O0, O1, PW) do { \
        float m4[4]; \
        _Pragma("unroll") for (int c = 0; c < 4; ++c) m4[c] = max2f(S0[c], S1[c]); \
        _Pragma("unroll") for (int r = 4; r < 16; ++r) m4[r & 3] = max2f(max2f(m4[r & 3], S0[r]), S1[r]); \
        float mx = xhalf_max(max2f(max2f(m4[0], m4[1]), max2f(m4[2], m4[3]))); \
        if (__any(mx - MREF > 8.0f)) { \
            const float mnew = max2f(mx, MREF); \
            const float f = __builtin_amdgcn_exp2f(MREF - mnew); \
            MREF = mnew; LSUM *= f; \
            _Pragma("unroll") for (int r = 0; r < 16; ++r) { O0[r] *= f; O1[r] *= f; } \
        } \
        float ps = 0.f; \
        _Pragma("unroll") for (int r = 0; r < 16; ++r) { S0[r] = __builtin_amdgcn_exp2f(S0[r] - MREF); S1[r] = __builtin_amdgcn_exp2f(S1[r] - MREF); ps += S0[r] + S1[r]; } \
        LSUM += ps; \
        _Pragma("unroll") for (int j = 0; j < 4; ++j) { PW[0][j] = cvt_pk_bf16(S0[2 * j], S0[2 * j + 1]); PW[1][j] = cvt_pk_bf16(S0[8 + 2 * j], S0[8 + 2 * j + 1]); \
                                                        PW[2][j] = cvt_pk_bf16(S1[2 * j], S1[2 * j + 1]); PW[3][j] = cvt_pk_bf16(S1[8 + 2 * j], S1[8 + 2 * j + 1]); } \
    } while (0)
        SOFTMAX2(sa0, sa1, ma, la, oa0, oa1, pa);
        SOFTMAX2(sb0, sb1, mb, lb, ob0, ob1, pb);
#undef SOFTMAX2
        const LAS unsigned char* va = lds + sc + va_off;
#pragma unroll
        for (int st = 0; st < 4; ++st) {
            const bf16x8 v0 = *(const LAS bf16x8*)(va + st * 32);
            const bf16x8 v1 = *(const LAS bf16x8*)(va + 32 * VROW + st * 32);
            const bf16x8 fa = __builtin_bit_cast(bf16x8, pa[st]), fb = __builtin_bit_cast(bf16x8, pb[st]);
            oa0 = __builtin_amdgcn_mfma_f32_32x32x16_bf16(v0, fa, oa0, 0, 0, 0);
            oa1 = __builtin_amdgcn_mfma_f32_32x32x16_bf16(v1, fa, oa1, 0, 0, 0);
            ob0 = __builtin_amdgcn_mfma_f32_32x32x16_bf16(v0, fb, ob0, 0, 0, 0);
            ob1 = __builtin_amdgcn_mfma_f32_32x32x16_bf16(v1, fb, ob1, 0, 0, 0);
        }
        __builtin_amdgcn_sched_barrier(0);
        __syncthreads();
        { const int tmp = sc; sc = sn; sn = snn; snn = tmp; }
    }
#undef ROWBASE
#undef DMAT
    const float inva = __builtin_amdgcn_rcpf(xhalf_sum(la)), invb = __builtin_amdgcn_rcpf(xhalf_sum(lb));
    bf16_t* op = MIX + (size_t)(qrow0 + wid * 64 + r32) * DM + h * 64 + 4 * hi;
#pragma unroll
    for (int g = 0; g < 4; ++g) {
        u32x2 w0, w1;
        w0.x = cvt_pk_bf16(oa0[4 * g] * inva, oa0[4 * g + 1] * inva); w0.y = cvt_pk_bf16(oa0[4 * g + 2] * inva, oa0[4 * g + 3] * inva);
        w1.x = cvt_pk_bf16(oa1[4 * g] * inva, oa1[4 * g + 1] * inva); w1.y = cvt_pk_bf16(oa1[4 * g + 2] * inva, oa1[4 * g + 3] * inva);
        *(u32x2*)(op + 8 * g) = w0; *(u32x2*)(op + 32 + 8 * g) = w1;
        w0.x = cvt_pk_bf16(ob0[4 * g] * invb, ob0[4 * g + 1] * invb); w0.y = cvt_pk_bf16(ob0[4 * g + 2] * invb, ob0[4 * g + 3] * invb);
        w1.x = cvt_pk_bf16(ob1[4 * g] * invb, ob1[4 * g + 1] * invb); w1.y = cvt_pk_bf16(ob1[4 * g + 2] * invb, ob1[4 * g + 3] * invb);
        *(u32x2*)(op + (size_t)32 * DM + 8 * g) = w0; *(u32x2*)(op + (size_t)32 * DM + 32 + 8 * g) = w1;
    }
}

enum { MAP_ID = 0, MAP_SWIGLU, MAP_WIN, MAP_UPQ, MAP_UPK, MAP_VT };
__device__ __forceinline__ int lmap(int p) { const int fq = p >> 3, nn = (p >> 2) & 1, j = p & 3; return 16 * (fq >> 1) + 8 * nn + 4 * (fq & 1) + j; }
template <int MAP> __device__ __forceinline__ int map_col(int n) {
    if (MAP == MAP_ID) return n;
    if (MAP == MAP_SWIGLU) { const int t = n >> 8, bj = (n >> 7) & 1, i = n & 127; return bj * DFF + 128 * t + i; }
    if (MAP == MAP_WIN) { if (n >= DIN) return -1; if (n >= 384 && n < 416) return 384 + lmap(n - 384); return n; }
    if (MAP == MAP_UPQ) { const int hh = n / 96, r = n % 96; return r < 64 ? n : hh * 96 + 64 + lmap(r - 64); }
    if (MAP == MAP_UPK) return (n >> 6) * 128 + (n & 63);
    return (n >> 6) * 128 + 64 + (n & 63);
}
template <int MAP> __device__ __forceinline__ void tr_item(const float* __restrict__ W, int Nsrc, const float* __restrict__ kscale, bf16_t* __restrict__ dst, int ldd, int kdst0, int nblk,
                                                           LAS float* scr, int item, int lane) {
    const int kb = item / nblk, nb = item % nblk, k0 = 64 * kb, n0 = 32 * nb;
    const int q4 = lane & 7, kr = lane >> 3;
    const int src = map_col<MAP>(n0 + 4 * q4);
    f32x4 tv[8];
#pragma unroll
    for (int i = 0; i < 8; ++i) { const int kk = 8 * i + kr; tv[i] = (src >= 0) ? *(const f32x4*)(W + (size_t)(k0 + kk) * Nsrc + src) : (f32x4){0.f, 0.f, 0.f, 0.f}; }
#pragma unroll
    for (int i = 0; i < 8; ++i) { const int kk = 8 * i + kr; f32x4 v = tv[i]; if (kscale) v = v * kscale[k0 + kk];
        scr[kk * 33 + 4 * q4 + 0] = v.x; scr[kk * 33 + 4 * q4 + 1] = v.y; scr[kk * 33 + 4 * q4 + 2] = v.z; scr[kk * 33 + 4 * q4 + 3] = v.w; }
    asm volatile("s_waitcnt lgkmcnt(0)" ::: "memory");
    const int c = lane & 7;
#pragma unroll
    for (int j = 0; j < 4; ++j) { const int n = (lane >> 3) + 8 * j; const LAS float* s = scr + (8 * c) * 33 + n;
        u32x4 o; o.x = cvt_pk_bf16(s[0 * 33], s[1 * 33]); o.y = cvt_pk_bf16(s[2 * 33], s[3 * 33]); o.z = cvt_pk_bf16(s[4 * 33], s[5 * 33]); o.w = cvt_pk_bf16(s[6 * 33], s[7 * 33]);
        *(u32x4*)(dst + (size_t)(n0 + n) * ldd + kdst0 + k0 + 8 * c) = o; }
    asm volatile("s_waitcnt lgkmcnt(0)" ::: "memory");
}

struct Args { const float* in[19]; float* out; unsigned char* ws; int ph_lo, ph_hi; };

__global__ void __launch_bounds__(512, 2) mega_fwd(Args a_byval) {
    extern __shared__ __attribute__((aligned(16))) unsigned char lds_raw[];
    cg::grid_group grid = cg::this_grid();
    const int ph_lo = a_byval.ph_lo, ph_hi = a_byval.ph_hi;
    const int wave0 = __builtin_amdgcn_readfirstlane((int)threadIdx.x >> 6);
    const int it_hi = ph_hi + (PROBE_DUP >= 0 ? 1 : 0);
    for (int it = ph_lo; it < it_hi; ++it) {
    const int ph = (PROBE_DUP >= 0 && it > PROBE_DUP) ? it - 1 : it;
    const __attribute__((address_space(4))) unsigned char* kap = (const __attribute__((address_space(4))) unsigned char*)__builtin_amdgcn_kernarg_segment_ptr();
    asm volatile("" : "+s"(kap));
    const __attribute__((address_space(4))) Args& a = *(const __attribute__((address_space(4))) Args*)kap;
    LAS unsigned char* lds = (LAS unsigned char*)lds_raw;
    const int wave = wave0;
    int G = gridDim.x, bx = blockIdx.x; asm volatile("" : "+s"(G), "+s"(bx));
    const int vcu = (G % 8 == 0) ? (bx % 8) * (G / 8) + bx / 8 : bx;
    const int gw = vcu * 8 + wave, NGW = G * 8;
    const int gwm = wave * G + vcu;
    unsigned char* ws = a.ws;
    float* mod = (float*)(ws + WS_MOD);
    float* rope = (float*)(ws + WS_ROPE);
    float* sWall = (float*)(ws + WS_SW);
    float* ssqp = (float*)(ws + WS_SSQP);
    float* ssqq = (float*)(ws + WS_SSQQ);
    float* ssqkv = (float*)(ws + WS_SSQKV);
    float* xctx = (float*)(ws + WS_XCTX);
    bf16_t* Xw = (bf16_t*)(ws + WS_XW);
    bf16_t* Qb = (bf16_t*)(ws + WS_XW);
    bf16_t* Hb = (bf16_t*)(ws + WS_H);
    bf16_t* Pb = (bf16_t*)(ws + WS_P);
    bf16_t* KNb = (bf16_t*)(ws + WS_KN);
    bf16_t* KPEb = (bf16_t*)(ws + WS_KPE);
    bf16_t* VTb = (bf16_t*)(ws + WS_VT);
    bf16_t* MIXb = (bf16_t*)(ws + WS_MIX);
    const float* x_in = a.in[0]; const float* ctx_in = a.in[2];
    const float* norm_w = a.in[6];
    {
        if (ph == 0) {
            const int lane = fresh_lane(); const int tid = wave0 * 64 + lane; (void)tid; (void)lane;
            LAS float* scr = (LAS float*)(lds + wave * 16384);
            constexpr int I1 = 2816, I2 = 1408, I5 = 1024, I6 = 96, I8 = 32, I12 = 512;
            constexpr int PER_L = 2 * I1 + 2 * I2 + I5 + I6 + 2 * I8 + I12;
            constexpr int N_TR = 2 * PER_L, N_ADA = 2 * 144 * 8, N_ALL = N_TR + N_ADA + 1;
            for (int it = gw; it < N_ALL; it += NGW) {
                if (it < N_TR) {
                    const int l = it / PER_L; int r = it % PER_L;
                    unsigned char* wl = ws + WS_W + (size_t)l * W_L;
                    unsigned char* wu = ws + WS_WUP + (size_t)l * WUP_L;
                    if (r < I1) { tr_item<MAP_SWIGLU>(a.in[7] + (size_t)l * DM * NFF, NFF, nullptr, (bf16_t*)(wl + W_1IN), DM, 0, NFF / 32, scr, r, lane); continue; } r -= I1;
                    if (r < I2) { tr_item<MAP_ID>(a.in[8] + (size_t)l * DFF * DM, DM, nullptr, (bf16_t*)(wl + W_1OUT), DFF, 0, DM / 32, scr, r, lane); continue; } r -= I2;
                    if (r < I1) { tr_item<MAP_SWIGLU>(a.in[9] + (size_t)l * DM * NFF, NFF, nullptr, (bf16_t*)(wl + W_2IN), DM, 0, NFF / 32, scr, r, lane); continue; } r -= I1;
                    if (r < I2) { tr_item<MAP_ID>(a.in[10] + (size_t)l * DFF * DM, DM, nullptr, (bf16_t*)(wl + W_2OUT), DFF, 0, DM / 32, scr, r, lane); continue; } r -= I2;
                    if (r < I5) { tr_item<MAP_WIN>(a.in[11] + (size_t)l * DM * DIN, DIN, nullptr, (bf16_t*)(wl + W_IN), DM, 0, DINP / 32, scr, r, lane); continue; } r -= I5;
                    if (r < I6) { tr_item<MAP_UPQ>(a.in[14] + (size_t)l * 256 * 768, 768, a.in[12] + l * 256, (bf16_t*)wu, KUP, 0, 768 / 32, scr, r, lane); continue; } r -= I6;
                    if (r < I8) { tr_item<MAP_UPK>(a.in[15] + (size_t)l * 128 * 1024, 1024, a.in[13] + l * 128, (bf16_t*)wu + 768 * KUP, KUP, 256, 512 / 32, scr, r, lane); continue; } r -= I8;
                    if (r < I8) { tr_item<MAP_VT>(a.in[15] + (size_t)l * 128 * 1024, 1024, a.in[13] + l * 128, (bf16_t*)(wu + WUP_VT), KUP, 256, 512 / 32, scr, r, lane); continue; } r -= I8;
                    tr_item<MAP_ID>(a.in[17] + (size_t)l * DM * DM, DM, nullptr, (bf16_t*)(wl + W_OUT), DM, 0, DM / 32, scr, r, lane);
                } else if (it < N_TR + N_ADA) {
                    int r = it - N_TR; const int l = r / 1152; r %= 1152; const int cgp = r >> 3, kc = r & 7, j = 64 * cgp + lane, k0 = 128 * kc;
#pragma unroll
                    for (int i2 = 0; i2 < 2; ++i2) { const int k = k0 + lane + 64 * i2; const float c0 = a.in[1][k], c1 = a.in[1][DM + k], c2 = a.in[3][k];
                        scr[lane + 64 * i2] = c0 / (1.0f + __expf(-c0)); scr[128 + lane + 64 * i2] = c1 / (1.0f + __expf(-c1)); scr[256 + lane + 64 * i2] = c2 / (1.0f + __expf(-c2)); }
                    asm volatile("s_waitcnt lgkmcnt(0)" ::: "memory");
                    float a0 = 0.f, a1 = 0.f, a2 = 0.f;
                    const float* wp = a.in[4] + ((size_t)l * DM + k0) * NMOD + j;
                    for (int kb = 0; kb < 128; kb += 32) {
                        float wv[32];
#pragma unroll
                        for (int kk = 0; kk < 32; ++kk) wv[kk] = wp[(size_t)(kb + kk) * NMOD];
#pragma unroll
                        for (int kk = 0; kk < 32; ++kk) { a0 += scr[kb + kk] * wv[kk]; a1 += scr[128 + kb + kk] * wv[kk]; a2 += scr[256 + kb + kk] * wv[kk]; }
                    }
                    if (kc == 0) { const float bb = a.in[5][l * NMOD + j]; a0 += bb; a1 += bb; a2 += bb; }
                    atomicAdd(mod + (size_t)(l * 3 + 0) * NMOD + j, a0); atomicAdd(mod + (size_t)(l * 3 + 1) * NMOD + j, a1); atomicAdd(mod + (size_t)(l * 3 + 2) * NMOD + j, a2);
                    asm volatile("s_waitcnt lgkmcnt(0)" ::: "memory");
                } else {
                    for (int e = lane; e < 1024; e += 64) {
                        const int pos = e >> 3, i = e & 7;
                        float th = (i & 1) ? 0.31622776601683794f : 1.0f;
                        for (int q = 0; q < (i >> 1); ++q) th *= 0.1f;
                        const float x2 = th * th;
                        const float c1 = 1.0f + x2 * (-0.5f + x2 * (4.1666666666666664e-2f + x2 * (-1.3888888888888889e-3f + x2 * (2.4801587301587302e-5f + x2 * (-2.7557319223985888e-7f + x2 * 2.08767569878681e-9f)))));
                        const float s1 = th * (1.0f + x2 * (-1.6666666666666666e-1f + x2 * (8.3333333333333332e-3f + x2 * (-1.9841269841269841e-4f + x2 * (2.7557319223985893e-6f + x2 * (-2.505210838544172e-8f + x2 * 1.6059043836821613e-10f))))));
                        float c = 1.0f, sn = 0.0f;
                        for (int bit = 6; bit >= 0; --bit) {
                            const float c2 = c * c - sn * sn, s2 = 2.0f * c * sn; c = c2; sn = s2;
                            if ((pos >> bit) & 1) { const float c3 = c * c1 - sn * s1, s3 = sn * c1 + c * s1; c = c3; sn = s3; }
                        }
                        rope[2 * e] = c; rope[2 * e + 1] = sn;
                    }
                }
            }
        } else if (ph == 1) {
            const int lane = fresh_lane(); const int tid = wave0 * 64 + lane; (void)tid; (void)lane;
            constexpr int N_SW = 2 * 832, N_X4 = MT / 4;
            for (int it = gw; it < N_SW + N_X4; it += NGW) {
                if (it < N_SW) {
                    const int l = it / 832; int r = it % 832;
                    const bf16_t* Bt; int chunk, N, n0; float* outp;
                    unsigned char* wl = ws + WS_W + (size_t)l * W_L;
                    if (r < 352) { Bt = (const bf16_t*)(wl + W_1IN); chunk = 0; N = NFF; n0 = 16 * r; outp = sWall + l * SW_L; }
                    else if (r < 704) { Bt = (const bf16_t*)(wl + W_2IN); chunk = 6; N = NFF; n0 = 16 * (r - 352); outp = sWall + l * SW_L + 3 * NFF; }
                    else { Bt = (const bf16_t*)(wl + W_IN); chunk = 3; N = DINP; n0 = 16 * (r - 704); outp = sWall + l * SW_L + 6 * NFF; }
                    f32x4 sh[3][4];
#pragma unroll
                    for (int s = 0; s < 3; ++s)
#pragma unroll
                        for (int q = 0; q < 4; ++q) sh[s][q] = *(const f32x4*)(mod + (size_t)(l * 3 + s) * NMOD + chunk * DM + 16 * lane + 4 * q);
#pragma unroll 1
                    for (int r4 = 0; r4 < 16; r4 += 4) {
                        u32x4 w0[4], w1[4];
#pragma unroll
                        for (int j = 0; j < 4; ++j) { w0[j] = *(const u32x4*)(Bt + (size_t)(n0 + r4 + j) * DM + 16 * lane); w1[j] = *(const u32x4*)(Bt + (size_t)(n0 + r4 + j) * DM + 16 * lane + 8); }
                        float d[4][3];
#pragma unroll
                        for (int j = 0; j < 4; ++j) {
                            const f32x4 f0 = (f32x4){bf_lo(w0[j].x), bf_hi(w0[j].x), bf_lo(w0[j].y), bf_hi(w0[j].y)}, f1 = (f32x4){bf_lo(w0[j].z), bf_hi(w0[j].z), bf_lo(w0[j].w), bf_hi(w0[j].w)};
                            const f32x4 f2 = (f32x4){bf_lo(w1[j].x), bf_hi(w1[j].x), bf_lo(w1[j].y), bf_hi(w1[j].y)}, f3 = (f32x4){bf_lo(w1[j].z), bf_hi(w1[j].z), bf_lo(w1[j].w), bf_hi(w1[j].w)};
#pragma unroll
                            for (int s = 0; s < 3; ++s) d[j][s] = sum4(f0 * sh[s][0] + f1 * sh[s][1] + f2 * sh[s][2] + f3 * sh[s][3]);
                        }
#pragma unroll
                        for (int o = 1; o < 64; o <<= 1)
#pragma unroll
                            for (int j = 0; j < 4; ++j)
#pragma unroll
                                for (int s = 0; s < 3; ++s) d[j][s] += shx(d[j][s], o, lane);
                        if (lane == 0) {
#pragma unroll
                            for (int j = 0; j < 4; ++j) { outp[n0 + r4 + j] = d[j][0]; outp[N + n0 + r4 + j] = d[j][1]; outp[2 * N + n0 + r4 + j] = d[j][2]; }
                        }
                    }
                } else {
                    const int m0 = 4 * (it - N_SW); const int s = m0 < SEQ ? 0 : (m0 < ML ? 1 : 2);
                    const float* src = m0 < ML ? x_in + (size_t)m0 * DM : ctx_in + (size_t)(m0 - ML) * DM;
                    f32x4 v[4][4], wm[4];
#pragma unroll
                    for (int rr = 0; rr < 4; ++rr)
#pragma unroll
                        for (int j = 0; j < 4; ++j) v[rr][j] = *(const f32x4*)(src + (size_t)rr * DM + 4 * lane + 256 * j);
#pragma unroll
                    for (int j = 0; j < 4; ++j) { const int col = 4 * lane + 256 * j; wm[j] = (*(const f32x4*)(norm_w + col)) * (*(const f32x4*)(mod + (size_t)s * NMOD + DM + col) + 1.0f); }
                    float q[4];
#pragma unroll
                    for (int rr = 0; rr < 4; ++rr) {
                        q[rr] = (dot4(v[rr][0]) + dot4(v[rr][1])) + (dot4(v[rr][2]) + dot4(v[rr][3]));
#pragma unroll
                        for (int j = 0; j < 4; ++j) { const f32x4 y = v[rr][j] * wm[j]; u32x2 w; w.x = cvt_pk_bf16(y.x, y.y); w.y = cvt_pk_bf16(y.z, y.w); *(u32x2*)(Xw + (size_t)(m0 + rr) * DM + 4 * lane + 256 * j) = w; }
                    }
#pragma unroll
                    for (int o = 1; o < 64; o <<= 1)
#pragma unroll
                        for (int rr = 0; rr < 4; ++rr) q[rr] += shx(q[rr], o, lane);
                    const float qsel = (lane >> 4) == 0 ? q[0] : ((lane >> 4) == 1 ? q[1] : ((lane >> 4) == 2 ? q[2] : q[3]));
                    ssqp[(size_t)m0 * 16 + lane] = (lane & 15) == 0 ? qsel : 0.f;
                }
            }
        } else if (ph == 18) {
            const int lane = fresh_lane(); const int tid = wave0 * 64 + lane; (void)tid; (void)lane;
            const float* fnw = a.in[18];
            for (int m = gw; m < ML; m += NGW) {
                const float t = wave_sum(lane < 16 ? ssqp[(size_t)m * 16 + lane] : 0.f, lane);
                const float rr = rsqrtf(t * (1.0f / 1024.0f) + EPS);
#pragma unroll
                for (int j = 0; j < 4; ++j) { const int col = 4 * lane + 256 * j; float* p = a.out + (size_t)m * DM + col; *(f32x4*)p = *(const f32x4*)p * rr * (*(const f32x4*)(fnw + col)); }
            }
        } else {
            const int l = (ph - 2) >> 3, k = (ph - 2) & 7;
            unsigned char* wl = ws + WS_W + (size_t)l * W_L;
            unsigned char* wu = ws + WS_WUP + (size_t)l * WUP_L;
            const float* modl = mod + (size_t)l * 3 * NMOD;
            float* sWl = sWall + l * SW_L;
            pg8::StaticOrder S;
            if (k == 0 || k == 6) {
                const int lane = fresh_lane(); const int tid = wave0 * 64 + lane; (void)tid; (void)lane;
                const int M = (l == 1 && k == 6) ? ML : MT;
                pg8::Gemm g{Xw, (const bf16_t*)(wl + (k == 0 ? W_1IN : W_2IN)), M, NFF, DM, DM, DM};
                const bool piped = (G == 256);
                unsigned* cntf = (unsigned*)(ws + WS_CNT) + (l * 2 + (k == 0 ? 0 : 1)) * 128;
                S.init(M, NFF, G, bx, 4, piped ? 1 : 0);
                pg8::EpiSwiglu E{Hb, ssqp, sWl + (k == 0 ? 0 : 3 * NFF), piped ? cntf : nullptr};
                pg8::gemm_phase<pg8::EpiSwiglu>(lds, g, S, E, tid);
            } else if (k == 1 || k == 7 || k == 5) {
                const int lane = fresh_lane(); const int tid = wave0 * 64 + lane; (void)tid; (void)lane;
                const int M = (l == 1 && k != 1) ? ML : MT;
                const bool kw = (k == 5), k1 = (k == 1);
                const bf16_t* gA = kw ? MIXb : Hb;
                const bf16_t* gB = (const bf16_t*)(wl + (kw ? W_OUT : (k1 ? W_1OUT : W_2OUT)));
                const int gK = kw ? DM : DFF;
                const float* xo_l = (k1 && l == 0) ? x_in : a.out;
                const float* xo_c = (k1 && l == 0) ? ctx_in : xctx;
                const float* gatep = modl + (kw ? 5 : (k1 ? 2 : 8)) * DM;
                const float* nwp = kw ? norm_w + (l * 3 + 2) * DM : (k1 ? norm_w + (l * 3 + 1) * DM : norm_w + 3 * DM);
                const float* nsp = kw ? modl + 7 * DM : (k1 ? modl + 4 * DM : mod + (size_t)3 * NMOD + DM);
                const bool has_ctx = (M == MT);
                const pg8::Gemm g{gA, gB, ML, DM, gK, gK, gK};
                const pg8::EpiResid E{xo_l, xo_c, a.out, xctx, gatep, nwp, nsp, Xw, ssqp, kw ? 1 : 0, (kw || k1 || l == 0) ? 1 : 0};
                const bool piped = (G == 256) && !kw;
                unsigned* cntf = (unsigned*)(ws + WS_CNT) + (l * 2 + (k1 ? 0 : 1)) * 128;
                if (piped) {
                    const int xq = bx & 7, tl = 31 - (bx >> 3), offp = (tl & 3) * 8 + (tl >> 2);
                    S.init(ML, DM, G, offp * 8 + xq);
                    pg8::Unit u0; S.next(0, u0);
                    if (tid == 0) {
                        unsigned spins = 0;
                        while (__hip_atomic_load(cntf + u0.pm, __ATOMIC_RELAXED, __HIP_MEMORY_SCOPE_AGENT) < 176u) { __builtin_amdgcn_s_sleep(8); if (++spins > (1u << 22)) break; }
                        __builtin_amdgcn_fence(__ATOMIC_ACQUIRE, "agent");
                        asm volatile("s_waitcnt vmcnt(0)" ::: "memory");
                    }
                    __syncthreads();
                } else S.init(ML, DM, G, bx);
                pg8::gemm_phase<pg8::EpiResid>(lds, g, S, E, tid);
                if (has_ctx) {
                    if (piped) {
                        const int offb = bx >> 3;
                        if (offb >= 24) {
                            if (wave0 == 0 && fresh_lane() == 0) {
                                unsigned spins = 0;
                                while (__hip_atomic_load(cntf + 64, __ATOMIC_RELAXED, __HIP_MEMORY_SCOPE_AGENT) < 176u || __hip_atomic_load(cntf + 65, __ATOMIC_RELAXED, __HIP_MEMORY_SCOPE_AGENT) < 176u) { __builtin_amdgcn_s_sleep(8); if (++spins > (1u << 22)) break; }
                                __builtin_amdgcn_fence(__ATOMIC_ACQUIRE, "agent");
                                asm volatile("s_waitcnt vmcnt(0)" ::: "memory");
                            }
                            __syncthreads();
                            pg8::skinny_ctx<pg8::EpiResid>(lds, g, E, DM / 256, (31 - offb) * 8 + (bx & 7), 64, wave0, fresh_lane());
                        }
                    } else pg8::skinny_ctx<pg8::EpiResid>(lds, g, E, DM / 256, bx, G, wave0, fresh_lane());
                }
            } else if (k == 2) {
                const int lane = fresh_lane(); const int tid = wave0 * 64 + lane; (void)tid; (void)lane;
                pg8::Gemm g{Xw, (const bf16_t*)(wl + W_IN), ML, DINP, DM, DM, DM};
                S.init(ML, DINP, G, bx);
                pg8::EpiInproj E{Pb, KPEb, ssqp, sWl + 6 * NFF, ssqq, ssqkv, rope};
                pg8::gemm_phase<pg8::EpiInproj>(lds, g, S, E, tid);
                if (l == 1) pg8::skinny_ctx<pg8::EpiInproj>(lds, g, E, 1, bx, G, wave0, fresh_lane(), 1);
                else pg8::skinny_ctx<pg8::EpiInproj>(lds, g, E, DINP / 256, bx, G, wave0, fresh_lane());
            } else if (k == 3) {
                const int tid = wave0 * 64 + fresh_lane();
                { const int Mq = (l == 1) ? ML : MT;
                  pg8::Gemm g{Pb, (const bf16_t*)wu, Mq, 768, 256, DINP, KUP};
                  S.init(Mq, 768, G, bx);
                  pg8::EpiUpQK E{Qb, KNb, ssqq, ssqkv, rope, 0};
                  pg8::gemm_phase<pg8::EpiUpQK>(lds, g, S, E, tid); }
                { pg8::Gemm g{Pb + 256, (const bf16_t*)wu + (size_t)768 * KUP + 256, MT, 512, 128, DINP, KUP};
                  S.init(MT, 512, G, G - 1 - bx);
                  pg8::EpiUpQK E{Qb, KNb, ssqq, ssqkv, rope, 3};
                  pg8::gemm_phase<pg8::EpiUpQK>(lds, g, S, E, wave0 * 64 + fresh_lane()); }
                { pg8::Gemm g{(const bf16_t*)(wu + WUP_VT) + 256, Pb + 256, 512, MT, 128, KUP, DINP};
                  S.init(512, MT, G, (G != 256) ? bx : (bx < 124 ? bx : (bx >= 248 ? bx - 124 : 4096)));
                  pg8::EpiVT E{VTb, ssqkv};
                  pg8::gemm_phase<pg8::EpiVT>(lds, g, S, E, wave0 * 64 + fresh_lane()); }
                const int lane = fresh_lane();
                const float* cw = a.in[16] + (size_t)l * 3 * 512 + 8 * lane;
                float w0[8], w1[8], w2[8];
#pragma unroll
                for (int c = 0; c < 8; ++c) { w0[c] = cw[c]; w1[c] = cw[512 + c]; w2[c] = cw[1024 + c]; }
                const int nit = (l == 1) ? ML / 8 : MT / 8;
                for (int it = gw; it < nit; it += NGW) {
                    const int m0 = 8 * it; const int Lm = (m0 < ML) ? (SEQ - 1) : 255;
                    const bool first = (m0 & Lm) == 0, last = ((m0 + 8) & Lm) == 0;
                    const bf16_t* pr = Pb + (size_t)m0 * DINP + 8 * lane;
                    u32x4 gcr[10], xvr[10], gbr[8];
#pragma unroll
                    for (int i = 0; i < 10; ++i) {
                        const bool valid = (i == 0) ? !first : ((i == 9) ? !last : true);
                        const bf16_t* rp = pr + (ptrdiff_t)(i - 1) * DINP;
                        gcr[i] = valid ? *(const u32x4*)(rp + 928) : (u32x4){0u, 0u, 0u, 0u};
                        xvr[i] = valid ? *(const u32x4*)(rp + 1440) : (u32x4){0u, 0u, 0u, 0u};
                    }
#pragma unroll
                    for (int i = 0; i < 8; ++i) gbr[i] = *(const u32x4*)(pr + (size_t)i * DINP + 416);
                    float up[8], uc[8], un[8];
#define MKU(dst, g_, x_) do { dst[0] = bf_lo(g_.x) * bf_lo(x_.x); dst[1] = bf_hi(g_.x) * bf_hi(x_.x); dst[2] = bf_lo(g_.y) * bf_lo(x_.y); dst[3] = bf_hi(g_.y) * bf_hi(x_.y); \
                        dst[4] = bf_lo(g_.z) * bf_lo(x_.z); dst[5] = bf_hi(g_.z) * bf_hi(x_.z); dst[6] = bf_lo(g_.w) * bf_lo(x_.w); dst[7] = bf_hi(g_.w) * bf_hi(x_.w); } while (0)
                    MKU(up, gcr[0], xvr[0]); MKU(uc, gcr[1], xvr[1]);
#pragma unroll
                    for (int i = 0; i < 8; ++i) {
                        MKU(un, gcr[i + 2], xvr[i + 2]);
                        const u32x4 gb = gbr[i];
                        float gbf[8] = {bf_lo(gb.x), bf_hi(gb.x), bf_lo(gb.y), bf_hi(gb.y), bf_lo(gb.z), bf_hi(gb.z), bf_lo(gb.w), bf_hi(gb.w)};
                        float y[8];
#pragma unroll
                        for (int c = 0; c < 8; ++c) { y[c] = gbf[c] * (w0[c] * up[c] + w1[c] * uc[c] + w2[c] * un[c]); up[c] = uc[c]; uc[c] = un[c]; }
                        u32x4 o; o.x = cvt_pk_bf16(y[0], y[1]); o.y = cvt_pk_bf16(y[2], y[3]); o.z = cvt_pk_bf16(y[4], y[5]); o.w = cvt_pk_bf16(y[6], y[7]);
                        *(u32x4*)(MIXb + (size_t)(m0 + i) * DM + 512 + 8 * lane) = o;
                    }
#undef MKU
                }
            } else {
                const int lane = fresh_lane(); const int tid = wave0 * 64 + lane; (void)tid; (void)lane;
                const int xcd = bx & 7, li = bx >> 3;
                if (G == 256) {
                    { const int bh = 2 * xcd + (li >> 4); attn_unit2(lds, Qb, KNb, KPEb, VTb, MIXb, bh >> 3, bh & 7, (bh >> 3) * SEQ + (li & 15) * 512, 132, tid); }
                } else {
                    for (int uidx = bx; uidx < 512; uidx += G) { const int bh = uidx >> 5; attn_unit(lds, Qb, KNb, KPEb, VTb, MIXb, bh >> 3, bh & 7, (bh >> 3) * SEQ + (uidx & 31) * 256, 132, tid); }
                }
                if (l == 0) for (int uidx = bx; uidx < 16; uidx += G) attn_unit(lds, Qb, KNb, KPEb, VTb, MIXb, uidx >> 3, uidx & 7, ML + (uidx >> 3) * 256, 4, tid);
            }
        }
        { const bool ffn_in_seam = (ph >= 2 && ph < 18 && (((ph - 2) & 7) == 0 || ((ph - 2) & 7) == 6)) && (int)gridDim.x == 256;
          if (it + 1 < it_hi && !ffn_in_seam) grid.sync(); }
    }
    }
}

extern "C" void kernel_launch(void* const* d_in, const int* in_sizes, int n_in, void* d_out, int out_size, void* d_ws, size_t ws_size, hipStream_t stream) {
    static int grid_blocks = 0;
    if (grid_blocks == 0) {
        if (n_in != 19 || out_size != ML * DM || ws_size < WS_END) { fprintf(stderr, "kernel_launch: unexpected shapes (n_in %d out %d ws %zu need %zu)\n", n_in, out_size, ws_size, (size_t)WS_END); grid_blocks = -1; return; }
        int dev = 0, cus = 0, per_cu = 0;
        hipGetDevice(&dev);
        hipDeviceGetAttribute(&cus, hipDeviceAttributeMultiprocessorCount, dev);
        hipFuncSetAttribute((const void*)mega_fwd, hipFuncAttributeMaxDynamicSharedMemorySize, LDS_BYTES);
        hipOccupancyMaxActiveBlocksPerMultiprocessor(&per_cu, (const void*)mega_fwd, 512, LDS_BYTES);
        if (per_cu < 1) { fprintf(stderr, "kernel_launch: occupancy query says %d blocks/CU\n", per_cu); per_cu = 1; }
        if (per_cu > 1) per_cu = 1;
        grid_blocks = cus * per_cu;
    }
    if (grid_blocks < 0) return;
    hipMemsetAsync(d_ws, 0, ZERO_BYTES, stream);
    Args a{};
    for (int i = 0; i < 19; ++i) a.in[i] = (const float*)d_in[i];
    a.out = (float*)d_out; a.ws = (unsigned char*)d_ws;
#if MK_PER_PHASE_LAUNCH
    for (int ph = 0; ph < 19; ++ph) {
        a.ph_lo = ph; a.ph_hi = ph + 1;
        void* args[] = {&a};
        hipError_t e = hipLaunchCooperativeKernel((const void*)mega_fwd, dim3(grid_blocks), dim3(512), args, LDS_BYTES, stream);
        if (e != hipSuccess) { fprintf(stderr, "launch failed: %s\n", hipGetErrorString(e)); break; }
    }
#else
    a.ph_lo = 0; a.ph_hi = 19;
    void* args[] = {&a};
    hipError_t e = hipLaunchCooperativeKernel((const void*)mega_fwd, dim3(grid_blocks), dim3(512), args, LDS_BYTES, stream);
    if (e != hipSuccess) fprintf(stderr, "cooperative launch failed: %s (grid %d)\n", hipGetErrorString(e), grid_blocks);
#endif
}
```
